# Optimizing an MI355X kernel written in HIP

```python
import math
import jax, jax.numpy as jnp
from jax import lax
import numpy as np

D_MODEL = 1024
BATCH = 16
SEQ = 4096
DEPTH = 4

GRID_W = 64
CTX_LEN = 256
N_EVEN = (DEPTH + 1) // 2
N_ODD = DEPTH // 2
EPS = 1e-6
ADA_CHUNKS = 6

H_A = 8
Q_LORA = 256
KV_LORA = 128
NOPE_DIM = 64
ROPE_DIM = 32
QK_DIM = NOPE_DIM + ROPE_DIM
V_DIM = 64
ROPE_BASE = 10000.0
Q_BLOCK = 128

H_R = 8
DK_R = 64
DV_R = 64
RET_CHUNK = 128
RET_W = H_R * DK_R

MLA_IN = Q_LORA + KV_LORA + ROPE_DIM
IN_WIDTH = MLA_IN + 4 * RET_W
MIX_W = H_A * V_DIM + H_R * DV_R

S5_GROUP = 16
S5_GROUPS = D_MODEL // S5_GROUP
S5_STATE = 64
S5_CHUNK = 128
DT_MIN = 1e-3
DT_MAX = 1e-1

D_FF = 4 * D_MODEL

kernel_name = 'hybrid_mla_retention_s5_dit'


def rmsnorm(x, g):
    xf = x.astype(jnp.float32)
    y = xf * lax.rsqrt(jnp.mean(xf * xf, axis=-1, keepdims=True) + EPS)
    return (y * g.astype(jnp.float32)).astype(x.dtype)


def head_norm(o):
    mu = jnp.mean(o, axis=-1, keepdims=True)
    var = jnp.mean(jnp.square(o - mu), axis=-1, keepdims=True)
    return (o - mu) * lax.rsqrt(var + EPS)


def modulate(h, shift, scale):
    return h * (1 + scale) + shift


def apply_rotary(x, ang):
    half = x.shape[-1] // 2
    cos = jnp.cos(ang)[None, :, None, :].astype(x.dtype)
    sin = jnp.sin(ang)[None, :, None, :].astype(x.dtype)
    x1, x2 = x[..., :half], x[..., half:]
    return jnp.concatenate([x1 * cos - x2 * sin, x1 * sin + x2 * cos], axis=-1)


def axial_angles(n_tok):
    rows = n_tok // GRID_W
    r = jnp.repeat(jnp.arange(rows, dtype=jnp.float32), GRID_W)
    col = jnp.tile(jnp.arange(GRID_W, dtype=jnp.float32), rows)
    nf = ROPE_DIM // 4
    f = ROPE_BASE ** (-jnp.arange(nf, dtype=jnp.float32) / nf)
    return jnp.concatenate([r[:, None] * f, col[:, None] * f], axis=-1)


def retnet_angles(n_tok):
    nf = DK_R // 2
    theta = ROPE_BASE ** (-jnp.arange(nf, dtype=jnp.float32) / nf)
    return jnp.arange(n_tok, dtype=jnp.float32)[:, None] * theta


def squared_relu_mlp(h, w1, w2):
    return jnp.square(jax.nn.relu(h @ w1)) @ w2


def mla_heads(z, q_norm_g, w_uq, kv_norm_g, w_ukv, qn_g, kn_g, ang):
    b, t = z.shape[:2]
    cq = z[..., :Q_LORA]
    ckv = z[..., Q_LORA:Q_LORA + KV_LORA]
    kr = z[..., Q_LORA + KV_LORA:]
    q = (rmsnorm(cq, q_norm_g) @ w_uq).reshape(b, t, H_A, QK_DIM)
    kv = (rmsnorm(ckv, kv_norm_g) @ w_ukv).reshape(b, t, H_A, NOPE_DIM + V_DIM)
    k = jnp.concatenate([kv[..., :NOPE_DIM], jnp.broadcast_to(kr[:, :, None, :], (b, t, H_A, ROPE_DIM))], axis=-1)
    v = kv[..., NOPE_DIM:]
    q = rmsnorm(q, qn_g)
    k = rmsnorm(k, kn_g)
    if ang is not None:
        q = jnp.concatenate([q[..., :NOPE_DIM], apply_rotary(q[..., NOPE_DIM:], ang)], axis=-1)
        k = jnp.concatenate([k[..., :NOPE_DIM], apply_rotary(k[..., NOPE_DIM:], ang)], axis=-1)
    return q, k, v


def attend(q, k, v):
    s = jnp.einsum('bqhd,bkhd->bhqk', q, k).astype(jnp.float32) * (QK_DIM ** -0.5)
    p = jax.nn.softmax(s, axis=-1).astype(v.dtype)
    return jnp.einsum('bhqk,bkhd->bqhd', p, v)


def blocked_attend(q, k, v):
    b, n_tok = q.shape[:2]
    nb = n_tok // Q_BLOCK
    qb = q.reshape(b, nb, Q_BLOCK, H_A, QK_DIM).swapaxes(0, 1)
    o = lax.map(lambda qq: attend(qq, k, v), qb)
    return o.swapaxes(0, 1).reshape(b, n_tok, H_A * V_DIM)


def ret_heads(z, ang):
    b, t = z.shape[:2]
    rq, rk, rv, rg = jnp.split(z, 4, axis=-1)
    rq = rq.reshape(b, t, H_R, DK_R).astype(jnp.float32)
    rk = rk.reshape(b, t, H_R, DK_R).astype(jnp.float32)
    rv = rv.reshape(b, t, H_R, DV_R).astype(jnp.float32)
    if ang is not None:
        rq = apply_rotary(rq, ang)
        rk = apply_rotary(rk, ang)
    return rq, rk * (DK_R ** -0.5), rv, rg


def retention_scan(q, k, v, log_gamma, s0, strict):
    b, t, h, _ = q.shape
    dv = v.shape[-1]
    n = t // RET_CHUNK
    i = jnp.arange(RET_CHUNK, dtype=jnp.float32)
    diff = i[:, None] - i[None, :]
    mask = (diff > 0) if strict else (diff >= 0)
    intra_decay = jnp.where(mask[None], jnp.exp(jnp.where(mask, diff, 0.0)[None] * log_gamma[:, None, None]), 0.0)
    q_decay = jnp.exp((i + 1)[:, None] * log_gamma[None])
    k_decay = jnp.exp((RET_CHUNK - 1 - i)[:, None] * log_gamma[None])
    chunk_decay = jnp.exp(RET_CHUNK * log_gamma)

    def blocks(a):
        return a.reshape(b, n, RET_CHUNK, h, a.shape[-1]).swapaxes(0, 1)

    def step(s, qkv):
        qc, kc, vc = qkv
        scores = jnp.einsum('bihd,bjhd->bhij', qc, kc) * intra_decay
        o = jnp.einsum('bhij,bjhe->bihe', scores, vc) + jnp.einsum('bihd,bhde->bihe', qc, s) * q_decay[None, :, :, None]
        s = s * chunk_decay[None, :, None, None] + jnp.einsum('bjhd,bjhe->bhde', kc * k_decay[None, :, :, None], vc)
        return s, o

    s_final, o = lax.scan(step, s0, (blocks(q), blocks(k), blocks(v)))
    return o.swapaxes(0, 1).reshape(b, t, h, dv), s_final


def ret_out(o, g):
    b, t = o.shape[:2]
    return head_norm(o).reshape(b, t, H_R * DV_R).astype(g.dtype) * jax.nn.silu(g)


def mla_retention_mixer(h_c, h_l, w_in, q_norm_g, w_uq, kv_norm_g, w_ukv, qn_g, kn_g, lg_f_raw, lg_b_raw, w_out, need_ctx):
    b, n_lat = h_l.shape[:2]
    z_c = h_c @ w_in
    z_l = h_l @ w_in
    q_c, k_c, v_c = mla_heads(z_c[..., :MLA_IN], q_norm_g, w_uq, kv_norm_g, w_ukv, qn_g, kn_g, None)
    q_l, k_l, v_l = mla_heads(z_l[..., :MLA_IN], q_norm_g, w_uq, kv_norm_g, w_ukv, qn_g, kn_g, axial_angles(n_lat))
    k_all = jnp.concatenate([k_c, k_l], axis=1)
    v_all = jnp.concatenate([v_c, v_l], axis=1)
    a_l = blocked_attend(q_l, k_all, v_all)
    lg_f = jnp.log1p(-jnp.exp2(lg_f_raw.astype(jnp.float32)))
    lg_b = jnp.log1p(-jnp.exp2(lg_b_raw.astype(jnp.float32)))
    rq_c, rk_c, rv_c, rg_c = ret_heads(z_c[..., MLA_IN:], None)
    rq_l, rk_l, rv_l, rg_l = ret_heads(z_l[..., MLA_IN:], retnet_angles(n_lat))
    zero = jnp.zeros((b, H_R, DK_R, DV_R), jnp.float32)
    o_cf, s_cf = retention_scan(rq_c, rk_c, rv_c, lg_f, zero, False)
    o_cb, s_cb = retention_scan(rq_c[:, ::-1], rk_c[:, ::-1], rv_c[:, ::-1], lg_b, zero, True)
    o_lf, _ = retention_scan(rq_l, rk_l, rv_l, lg_f, s_cf, False)
    o_lb, _ = retention_scan(rq_l[:, ::-1], rk_l[:, ::-1], rv_l[:, ::-1], lg_b, s_cb, True)
    r_l = ret_out(o_lf + o_lb[:, ::-1], rg_l)
    y_l = jnp.concatenate([a_l, r_l.astype(a_l.dtype)], axis=-1) @ w_out
    if need_ctx:
        a_c = attend(q_c, k_c, v_c).reshape(b, h_c.shape[1], H_A * V_DIM)
        r_c = ret_out(o_cf + o_cb[:, ::-1], rg_c)
        y_c = jnp.concatenate([a_c, r_c.astype(a_c.dtype)], axis=-1) @ w_out
    else:
        y_c = None
    return y_c, y_l


def s5_discretize(a_re, a_im, b_re, b_im, c_re, c_im, log_dt):
    f = lambda t: t.astype(jnp.float32)
    a = lax.complex(f(a_re), f(a_im))
    dt = jnp.exp(f(log_dt))[:, None]
    a_bar = jnp.exp(dt * a)
    b_bar = ((a_bar - 1) / a)[..., None] * lax.complex(f(b_re), f(b_im))
    c_mat = lax.complex(f(c_re), f(c_im))
    return a_bar, b_bar, c_mat


def _affine_compose(e1, e2):
    a1, b1 = e1
    a2, b2 = e2
    return a1 * a2, a2 * b1 + b2


def s5_scan(u, a_bar, b_bar, c_mat, x0):
    b, t = u.shape[:2]
    n = t // S5_CHUNK
    ub = u.reshape(b, n, S5_CHUNK, S5_GROUPS, S5_GROUP).swapaxes(0, 1)

    def step(x, u_blk):
        bu = jnp.einsum('btgh,gph->btgp', u_blk.astype(jnp.complex64), b_bar)
        bu = bu.at[:, 0].add(a_bar * x)
        a = jnp.broadcast_to(a_bar, bu.shape)
        _, xs = lax.associative_scan(_affine_compose, (a, bu), axis=1)
        y = jnp.einsum('btgp,ghp->btgh', xs, c_mat).real
        return xs[:, -1], y

    x_final, ys = lax.scan(step, x0, ub)
    return ys.swapaxes(0, 1).reshape(b, t, S5_GROUPS, S5_GROUP), x_final


def s5_out(y, u, d_skip, w_glu, dtype):
    b, t = u.shape[:2]
    y = (y + d_skip.astype(jnp.float32).reshape(S5_GROUPS, S5_GROUP) * u).reshape(b, t, D_MODEL)
    z = jax.nn.gelu(y).astype(dtype) @ w_glu
    za, zb = jnp.split(z, 2, axis=-1)
    return za * jax.nn.sigmoid(zb)


def s5_mixer(h_c, h_l, p_f, p_b, d_skip, w_glu, need_ctx):
    ab_f, bb_f, c_f = s5_discretize(*p_f)
    ab_b, bb_b, c_b = s5_discretize(*p_b)
    b = h_l.shape[0]
    u_c = h_c.astype(jnp.float32).reshape(b, h_c.shape[1], S5_GROUPS, S5_GROUP)
    u_l = h_l.astype(jnp.float32).reshape(b, h_l.shape[1], S5_GROUPS, S5_GROUP)
    x0 = jnp.zeros((b, S5_GROUPS, S5_STATE), jnp.complex64)
    y_cf, x_cf = s5_scan(u_c, ab_f, bb_f, c_f, x0)
    y_cb, x_cb = s5_scan(u_c[:, ::-1], ab_b, bb_b, c_b, x0)
    y_lf, _ = s5_scan(u_l, ab_f, bb_f, c_f, x_cf)
    y_lb, _ = s5_scan(u_l[:, ::-1], ab_b, bb_b, c_b, x_cb)
    out_l = s5_out(y_lf + y_lb[:, ::-1], u_l, d_skip, w_glu, h_l.dtype)
    out_c = s5_out(y_cf + y_cb[:, ::-1], u_c, d_skip, w_glu, h_c.dtype) if need_ctx else None
    return out_c, out_l


def setup_inputs(seed: int = 0) -> dict:
    key = jax.random.key(seed)
    ks = iter(jax.random.split(key, 48))
    f32 = jnp.float32

    def nrm(shape, scale=1.0):
        return jax.random.normal(next(ks), shape, f32) * scale

    def gain(shape):
        return 1.0 + nrm(shape, 0.02)

    D = D_MODEL
    G, P, Hg = S5_GROUPS, S5_STATE, S5_GROUP
    n_idx = jnp.arange(P, dtype=f32)
    decay_init = -(5.0 + jnp.arange(H_R, dtype=f32))
    inputs = {
        'x': nrm((BATCH, SEQ, D)),
        'c': nrm((BATCH, D)),
        'ctx': nrm((BATCH, CTX_LEN, D)),
        'c_ctx': nrm((D,)),
        'ada_w': nrm((DEPTH, D, ADA_CHUNKS * D), 0.5 * D ** -0.5),
        'ada_b': nrm((DEPTH, ADA_CHUNKS * D), 0.02),
        'norm1_g': gain((DEPTH, D)),
        'norm2_g': gain((DEPTH, D)),
        'mlp_w1': nrm((DEPTH, D, D_FF), D ** -0.5),
        'mlp_w2': nrm((DEPTH, D_FF, D), D_FF ** -0.5),
        'w_in': nrm((N_EVEN, D, IN_WIDTH), D ** -0.5),
        'mla_q_norm_g': gain((N_EVEN, Q_LORA)),
        'mla_w_uq': nrm((N_EVEN, Q_LORA, H_A * QK_DIM), Q_LORA ** -0.5),
        'mla_kv_norm_g': gain((N_EVEN, KV_LORA)),
        'mla_w_ukv': nrm((N_EVEN, KV_LORA, H_A * (NOPE_DIM + V_DIM)), KV_LORA ** -0.5),
        'mla_qn_g': gain((N_EVEN, QK_DIM)),
        'mla_kn_g': gain((N_EVEN, QK_DIM)),
        'ret_lg_f': decay_init + nrm((N_EVEN, H_R), 0.1),
        'ret_lg_b': decay_init + nrm((N_EVEN, H_R), 0.1),
        'w_out': nrm((N_EVEN, MIX_W, D), MIX_W ** -0.5),
    }
    for d in ('f', 'b'):
        inputs['s5_a_re_' + d] = -0.5 + nrm((N_ODD, G, P), 0.01)
        inputs['s5_a_im_' + d] = jnp.pi * n_idx + nrm((N_ODD, G, P), 0.01)
        inputs['s5_b_re_' + d] = nrm((N_ODD, G, P, Hg), (2 * Hg) ** -0.5)
        inputs['s5_b_im_' + d] = nrm((N_ODD, G, P, Hg), (2 * Hg) ** -0.5)
        inputs['s5_c_re_' + d] = nrm((N_ODD, G, Hg, P), P ** -0.5)
        inputs['s5_c_im_' + d] = nrm((N_ODD, G, Hg, P), P ** -0.5)
        inputs['s5_log_dt_' + d] = math.log(DT_MIN) + jax.random.uniform(next(ks), (N_ODD, G), f32) * (math.log(DT_MAX) - math.log(DT_MIN))
    inputs['s5_d'] = nrm((N_ODD, D))
    inputs['s5_w_glu'] = nrm((N_ODD, D, 2 * D), D ** -0.5)
    return inputs


def reference(x, c, ctx, c_ctx, ada_w, ada_b, norm1_g, norm2_g, mlp_w1, mlp_w2, w_in, mla_q_norm_g, mla_w_uq, mla_kv_norm_g, mla_w_ukv, mla_qn_g, mla_kn_g, ret_lg_f, ret_lg_b, w_out, s5_a_re_f, s5_a_im_f, s5_b_re_f, s5_b_im_f, s5_c_re_f, s5_c_im_f, s5_log_dt_f, s5_a_re_b, s5_a_im_b, s5_b_re_b, s5_b_im_b, s5_c_re_b, s5_c_im_b, s5_log_dt_b, s5_d, s5_w_glu):
    xc = ctx
    b = x.shape[0]
    for l in range(DEPTH):
        need_ctx = l < DEPTH - 1
        mod_l = (jax.nn.silu(c) @ ada_w[l] + ada_b[l]).reshape(b, ADA_CHUNKS, 1, D_MODEL)
        mod_c = (jax.nn.silu(c_ctx) @ ada_w[l] + ada_b[l]).reshape(ADA_CHUNKS, D_MODEL)
        h_l = modulate(rmsnorm(x, norm1_g[l]), mod_l[:, 0], mod_l[:, 1])
        h_c = modulate(rmsnorm(xc, norm1_g[l]), mod_c[0], mod_c[1])
        if l % 2 == 0:
            e = l // 2
            o_c, o_l = mla_retention_mixer(h_c, h_l, w_in[e], mla_q_norm_g[e], mla_w_uq[e], mla_kv_norm_g[e], mla_w_ukv[e], mla_qn_g[e], mla_kn_g[e], ret_lg_f[e], ret_lg_b[e], w_out[e], need_ctx)
        else:
            o = l // 2
            p_f = (s5_a_re_f[o], s5_a_im_f[o], s5_b_re_f[o], s5_b_im_f[o], s5_c_re_f[o], s5_c_im_f[o], s5_log_dt_f[o])
            p_b = (s5_a_re_b[o], s5_a_im_b[o], s5_b_re_b[o], s5_b_im_b[o], s5_c_re_b[o], s5_c_im_b[o], s5_log_dt_b[o])
            o_c, o_l = s5_mixer(h_c, h_l, p_f, p_b, s5_d[o], s5_w_glu[o], need_ctx)
        x = x + mod_l[:, 2] * o_l
        h_l = modulate(rmsnorm(x, norm2_g[l]), mod_l[:, 3], mod_l[:, 4])
        x = x + mod_l[:, 5] * squared_relu_mlp(h_l, mlp_w1[l], mlp_w2[l])
        if need_ctx:
            xc = xc + mod_c[2] * o_c
            h_c = modulate(rmsnorm(xc, norm2_g[l]), mod_c[3], mod_c[4])
            xc = xc + mod_c[5] * squared_relu_mlp(h_c, mlp_w1[l], mlp_w2[l])
    return x
```

```cpp
#include <hip/hip_runtime.h>
#include <hip/hip_cooperative_groups.h>
#include <cstdio>
#include <cstdint>
#include <type_traits>
namespace cg = cooperative_groups;

#define LAS __attribute__((address_space(3)))
#define DI __device__ __forceinline__
typedef unsigned short bf16_t;
typedef short bf16x8 __attribute__((ext_vector_type(8)));
typedef short s16x4 __attribute__((ext_vector_type(4)));
typedef float f32x4 __attribute__((ext_vector_type(4)));
typedef float f32x2 __attribute__((ext_vector_type(2)));
typedef float f32x16 __attribute__((ext_vector_type(16)));
typedef unsigned u32x4 __attribute__((ext_vector_type(4)));
typedef unsigned u32x2 __attribute__((ext_vector_type(2)));
typedef __bf16 bf16x2_t __attribute__((ext_vector_type(2)));

constexpr int NB = 16, T = 4096, TC = 256, D = 1024, FF = 4096;
constexpr int ML = NB * T, MC = NB * TC, M = ML + MC, TK = T + TC;
constexpr int ZW = 2560;
constexpr float EPS = 1e-6f;
constexpr float LOG2E = 1.4426950408889634f;
constexpr float QSCALE = 0.10206207261596575f * LOG2E;
constexpr int NTHREADS = 512;
constexpr int LDS_BYTES = 135168;

constexpr size_t OFF_W1T = 0;
constexpr size_t OFF_W2T = OFF_W1T + (size_t)4 * FF * D * 2;
constexpr size_t OFF_WINT = OFF_W2T + (size_t)4 * FF * D * 2;
constexpr size_t OFF_WUQT = OFF_WINT + (size_t)2 * ZW * D * 2;
constexpr size_t OFF_WUKVT = OFF_WUQT + (size_t)2 * 768 * 256 * 2;
constexpr size_t OFF_WOUTT = OFF_WUKVT + (size_t)2 * 1024 * 256 * 2;
constexpr size_t OFF_WGLUT = OFF_WOUTT + (size_t)2 * D * D * 2;
constexpr size_t OFF_MOD = OFF_WGLUT + (size_t)2 * 2048 * D * 2;
constexpr size_t OFF_XC = OFF_MOD + (size_t)4 * 17 * 6144 * 4;
constexpr size_t OFF_TABR = OFF_XC + (size_t)MC * D * 4;
constexpr size_t OFF_TABA = OFF_TABR + (size_t)T * 32 * 8;
constexpr size_t OFF_BAR = OFF_TABA + (size_t)T * 16 * 8;
constexpr size_t BAR_BYTES = 16384;
constexpr size_t OFF_ARENA = OFF_BAR + BAR_BYTES;
constexpr size_t A_Z = 0;
constexpr size_t A_HB = A_Z + (size_t)M * ZW * 2;
constexpr size_t A_MIX = A_HB + (size_t)M * D * 2;
constexpr size_t A_Q = A_MIX + (size_t)M * 768 * 2 + (size_t)M * 384 * 2;
constexpr size_t A_K = A_Q + (size_t)M * 768 * 2;
constexpr size_t A_VT = A_K + (size_t)M * 768 * 2;
constexpr size_t A_END_EVEN = A_VT + (size_t)M * 512 * 2;
constexpr size_t A_H0 = 0;
constexpr size_t A_HID = A_H0 + (size_t)M * D * 2;
constexpr size_t A_PART = A_HID + (size_t)M * FF * 2;
constexpr size_t A_END_MLP = A_PART + (size_t)4 * MC * D * 4;
constexpr size_t A_YF = A_H0 + (size_t)M * D * 2;
constexpr size_t A_YB = A_YF + (size_t)M * D * 2;
constexpr size_t A_G = A_YB + (size_t)M * D * 2;
constexpr size_t WS_NEED = OFF_ARENA + (A_END_EVEN > A_END_MLP ? A_END_EVEN : A_END_MLP);
static_assert((size_t)M * 768 * 2 + (size_t)M * 384 * 2 >= (size_t)M * D * 2, "MIX fits its region");

struct KArgs { const float* in[36]; float* out; unsigned char* ws; };

DI unsigned pk2(float lo, float hi) { f32x2 v = {lo, hi}; bf16x2_t b = __builtin_convertvector(v, bf16x2_t); return __builtin_bit_cast(unsigned, b); }
DI float bflo(unsigned u) { return __uint_as_float(u << 16); }
DI float bfhi(unsigned u) { return __uint_as_float(u & 0xffff0000u); }
DI float bf1(bf16_t h) { return __uint_as_float(((unsigned)h) << 16); }
DI bf16_t f2bf(float f) { return (bf16_t)(pk2(f, 0.f) & 0xffffu); }
DI void unpack8(u32x4 v, float* f) { f[0] = bflo(v.x); f[1] = bfhi(v.x); f[2] = bflo(v.y); f[3] = bfhi(v.y); f[4] = bflo(v.z); f[5] = bfhi(v.z); f[6] = bflo(v.w); f[7] = bfhi(v.w); }
DI u32x4 pack8(const float* f) { u32x4 o; o.x = pk2(f[0], f[1]); o.y = pk2(f[2], f[3]); o.z = pk2(f[4], f[5]); o.w = pk2(f[6], f[7]); return o; }
DI float wave_sum(float v) {
#pragma unroll
    for (int o = 1; o < 64; o <<= 1) v += __shfl_xor(v, o);
    return v;
}
#define LDS_WAIT() asm volatile("s_waitcnt lgkmcnt(0)" ::: "memory")
DI float sin_rev(float r) { return __builtin_amdgcn_sinf(r); }
DI float cos_rev(float r) { return __builtin_amdgcn_cosf(r); }
#define MFMA16(a, b, c) __builtin_amdgcn_mfma_f32_16x16x32_bf16((a), (b), (c), 0, 0, 0)
#define MFMA32(a, b, c) __builtin_amdgcn_mfma_f32_32x32x16_bf16((a), (b), (c), 0, 0, 0)

namespace pg8 {
constexpr int BM = 256, BK = 64, HALF = 128, HTB = HALF * BK * 2, STAGE_BYTES = 8 * HTB, NXCD = 8, WGM = 8;
DI int lds_byte(int r, int c) { const int st = (r >> 4) * 2 + (c >> 5), rr = r & 15, cc = c & 31, ob = rr * 64 + cc * 2; return st * 1024 + (ob ^ (((ob >> 9) & 1) << 5)); }
DI void stage_rc(int b, int& R, int& C) { const int st = b / 1024, sb = b % 1024, swz = sb ^ (((sb >> 9) & 1) << 5); R = (st >> 1) * 16 + swz / 64; C = (st & 1) * 32 + (swz % 64) / 2; }
DI int perm32(int rho) { const int n = rho >> 4, i = rho & 15; return 8 * (i >> 2) + 4 * n + (i & 3); }
struct Unit { int pm, pn, ks; };
struct Gemm { const bf16_t* A; const bf16_t* Bt; int lda, ldb, M, N, K, ksplit; };
struct StaticOrder {
    int nM, nN, nNr, nwg, G, c;
    DI void init(int M_, int N_, int G_, int c_, int ksplit) { nM = M_ / BM; nNr = N_ / BM; nN = nNr * ksplit; nwg = nM * nN; G = G_; c = c_; }
    DI bool next(int i, Unit& u) const {
        const long L = (long)i * G + c; if (L >= nwg) return false;
        int wgid = (int)L; { const int q = nwg / NXCD, r = nwg % NXCD, xcd = wgid % NXCD, off = wgid / NXCD; wgid = (xcd < r ? xcd * (q + 1) : r * (q + 1) + (xcd - r) * q) + off; }
        const int nig = WGM * nN, gid = wgid / nig, fm = gid * WGM, gsz = (nM - fm) < WGM ? (nM - fm) : WGM;
        u.pm = fm + ((wgid % nig) % gsz); const int pv_ = (wgid % nig) / gsz; u.ks = pv_ / nNr; u.pn = pv_ - u.ks * nNr; return true;
    }
};
template <class Epi>
DI void gemm_phase(LAS unsigned char* lds, const int tid, const Gemm g, const StaticOrder& S, const Epi& E) {
    const int wid = __builtin_amdgcn_readfirstlane(tid >> 6), lane = tid & 63, wr = wid >> 2, wc = wid & 3, fr = lane & 15, fq = lane >> 4;
    const int K = g.K, nt = K / BK, lda = g.lda, ldb = g.ldb;
    unsigned voffA[2], voffB[2];
#pragma unroll
    for (int i = 0; i < 2; ++i) { int R, C; stage_rc(tid * 16 + i * 8192, R, C); const int Rb = (R & ~31) + perm32(R & 31);
        voffA[i] = (unsigned)(R * lda + C) * 2u; voffB[i] = (unsigned)(Rb * ldb + C) * 2u; }
    const size_t kstep = (size_t)(BK * 2);
    const size_t hstA = (size_t)HALF * lda * 2, hstB = (size_t)HALF * ldb * 2, ksb = (size_t)K * 2;
    const size_t tstA = 2 * hstA, tstB = 2 * hstB;
    const unsigned ldsw = (unsigned)wid * 1024u;
    const int aoff = lds_byte(wr * 64 + fr, fq * 8), boff = lds_byte(wc * 32 + fr, fq * 8);
#define PG8_SA(b, h) (((b) * 2 + (h)) * HTB)
#define PG8_SB(b, h) ((4 + (b) * 2 + (h)) * HTB)
#define PG8_STAGE(bufoff, gbase, voff) do { _Pragma("unroll") for (int _i = 0; _i < 2; ++_i) \
        __builtin_amdgcn_global_load_lds((const unsigned*)((const char*)(gbase) + (voff)[_i]), (LAS unsigned*)(lds + (bufoff) + ldsw + _i * 8192), 16, 0, 0); } while (0)
#define PG8_LDA(dst, b, h) do { _Pragma("unroll") for (int m = 0; m < 4; ++m) _Pragma("unroll") for (int k = 0; k < 2; ++k) dst[m][k] = *(const LAS bf16x8*)(lds + PG8_SA(b, h) + aoff + m * 2048 + k * 1024); } while (0)
#define PG8_LDB(dst, b, h) do { _Pragma("unroll") for (int n = 0; n < 2; ++n) _Pragma("unroll") for (int k = 0; k < 2; ++k) dst[n][k] = *(const LAS bf16x8*)(lds + PG8_SB(b, h) + boff + n * 2048 + k * 1024); } while (0)
#define PG8_MMA(ai, bj, At, Bt) do { __builtin_amdgcn_s_setprio(1); _Pragma("unroll") for (int m = 0; m < 4; ++m) _Pragma("unroll") for (int n = 0; n < 2; ++n) _Pragma("unroll") for (int k = 0; k < 2; ++k) \
        acc[ai][bj][m][n] = __builtin_amdgcn_mfma_f32_16x16x32_bf16(Bt[n][k], At[m][k], acc[ai][bj][m][n], 0, 0, 0); __builtin_amdgcn_s_setprio(0); } while (0)
#define PG8_WAIT_V(n) asm volatile("s_waitcnt vmcnt(" #n ")" ::: "memory")
#define PG8_WAIT_L(n) asm volatile("s_waitcnt lgkmcnt(" #n ")" ::: "memory")
#define PG8_BAR __builtin_amdgcn_s_barrier()
#define PG8_SCHED __builtin_amdgcn_sched_barrier(0)
    Unit cur, nxt; int ui = 0;
    if (!S.next(0, cur)) return;
    f32x4 acc[2][2][4][2];
#pragma unroll
    for (int a = 0; a < 2; ++a)
#pragma unroll
        for (int b = 0; b < 2; ++b)
#pragma unroll
            for (int m = 0; m < 4; ++m)
#pragma unroll
                for (int n = 0; n < 2; ++n) acc[a][b][m][n] = (f32x4){0.f, 0.f, 0.f, 0.f};
    bf16x8 At[4][2], B0[2][2], B1[2][2];
    const char* cA = (const char*)g.A + (size_t)cur.pm * tstA + (size_t)cur.ks * ksb; const char* cB = (const char*)g.Bt + (size_t)cur.pn * tstB + (size_t)cur.ks * ksb;
    PG8_STAGE(PG8_SB(0, 0), cB, voffB); PG8_STAGE(PG8_SB(0, 1), cB + hstB, voffB); PG8_STAGE(PG8_SA(0, 0), cA, voffA); PG8_STAGE(PG8_SA(0, 1), cA + hstA, voffA);
    if (wr == 1) PG8_BAR;
    PG8_WAIT_V(2); PG8_BAR;
    PG8_STAGE(PG8_SB(1, 0), cB + kstep, voffB); PG8_STAGE(PG8_SA(1, 0), cA + kstep, voffA); PG8_STAGE(PG8_SB(1, 1), cB + hstB + kstep, voffB);
    PG8_WAIT_V(6); PG8_BAR;
    for (;;) {
        const bool has_next = S.next(ui + 1, nxt);
        const char* nA = has_next ? (const char*)g.A + (size_t)nxt.pm * tstA + (size_t)nxt.ks * ksb : cA; const char* nB = has_next ? (const char*)g.Bt + (size_t)nxt.pn * tstB + (size_t)nxt.ks * ksb : cB;
        for (int t = 0; t < nt; t += 2) {
            const bool last = (t == nt - 2);
            const char* a1 = cA + (size_t)(t + 1) * kstep;
            const char* a2 = last ? nA : cA + (size_t)(t + 2) * kstep; const char* b2 = last ? nB : cB + (size_t)(t + 2) * kstep;
            const char* a3 = a2 + kstep; const char* b3 = b2 + kstep;
            PG8_LDB(B0, 0, 0); PG8_LDB(B1, 0, 1); PG8_SCHED; PG8_LDA(At, 0, 0); PG8_STAGE(PG8_SA(1, 1), a1 + hstA, voffA);
            PG8_WAIT_V(8); PG8_WAIT_L(0); PG8_BAR; PG8_MMA(0, 0, At, B0); PG8_MMA(0, 1, At, B1); PG8_BAR; PG8_SCHED;
            PG8_LDA(At, 0, 1); PG8_STAGE(PG8_SB(0, 0), b2, voffB); PG8_STAGE(PG8_SB(0, 1), b2 + hstB, voffB); PG8_STAGE(PG8_SA(0, 0), a2, voffA);
            PG8_WAIT_V(8); PG8_WAIT_L(0); PG8_BAR; PG8_MMA(1, 0, At, B0); PG8_MMA(1, 1, At, B1); PG8_BAR; PG8_SCHED;
            PG8_LDB(B0, 1, 0); PG8_LDB(B1, 1, 1); PG8_SCHED; PG8_LDA(At, 1, 0); PG8_STAGE(PG8_SA(0, 1), a2 + hstA, voffA);
            PG8_WAIT_V(8); PG8_WAIT_L(0); PG8_BAR; PG8_MMA(0, 0, At, B0); PG8_MMA(0, 1, At, B1); PG8_BAR; PG8_SCHED;
            PG8_LDA(At, 1, 1); PG8_STAGE(PG8_SB(1, 0), b3, voffB); PG8_STAGE(PG8_SB(1, 1), b3 + hstB, voffB); PG8_STAGE(PG8_SA(1, 0), a3, voffA);
            PG8_WAIT_V(8); PG8_WAIT_L(0); PG8_BAR; PG8_MMA(1, 0, At, B0); PG8_MMA(1, 1, At, B1); PG8_BAR; PG8_SCHED;
        }
        if (wr == 0) PG8_BAR;
        E(acc, cur, wr, wc, fr, fq);
        if (!has_next) break;
#pragma unroll
        for (int a = 0; a < 2; ++a)
#pragma unroll
            for (int b = 0; b < 2; ++b)
#pragma unroll
                for (int m = 0; m < 4; ++m)
#pragma unroll
                    for (int n = 0; n < 2; ++n) acc[a][b][m][n] = (f32x4){0.f, 0.f, 0.f, 0.f};
        cur = nxt; cA = nA; cB = nB; ++ui;
        if (wr == 1) PG8_BAR;
    }
    PG8_WAIT_V(0);
    PG8_BAR;
#undef PG8_SA
#undef PG8_SB
#undef PG8_STAGE
#undef PG8_LDA
#undef PG8_LDB
#undef PG8_MMA
#undef PG8_WAIT_V
#undef PG8_WAIT_L
#undef PG8_BAR
#undef PG8_SCHED
}

struct EpiStore {
    bf16_t* O; int ldc; int act;
    DI void operator()(const f32x4 (&acc)[2][2][4][2], const Unit& u, int wr, int wc, int fr, int fq) const {
        const int row0 = u.pm * BM + wr * 64 + fr, col0 = u.pn * BM + wc * 32 + 8 * fq;
#pragma unroll
        for (int ai = 0; ai < 2; ++ai)
#pragma unroll
            for (int m = 0; m < 4; ++m) { bf16_t* rowp = O + (size_t)(row0 + ai * HALF + m * 16) * ldc + col0;
#pragma unroll
                for (int bj = 0; bj < 2; ++bj) { f32x4 v0 = acc[ai][bj][m][0], v1 = acc[ai][bj][m][1];
                    if (act) {
#pragma unroll
                        for (int q = 0; q < 4; ++q) { float a = fmaxf(v0[q], 0.f), b = fmaxf(v1[q], 0.f); v0[q] = a * a; v1[q] = b * b; } }
                    u32x4 w; w.x = pk2(v0[0], v0[1]); w.y = pk2(v0[2], v0[3]); w.z = pk2(v1[0], v1[1]); w.w = pk2(v1[2], v1[3]);
                    *(u32x4*)(rowp + bj * HALF) = w; } }
    }
};
struct EpiPart {
    float* P; int rows;
    DI void operator()(const f32x4 (&acc)[2][2][4][2], const Unit& u, int wr, int wc, int fr, int fq) const {
        const int row0 = u.pm * BM + wr * 64 + fr, col0 = u.pn * BM + wc * 32 + 8 * fq;
        float* base = P + (size_t)u.ks * rows * D;
#pragma unroll
        for (int ai = 0; ai < 2; ++ai)
#pragma unroll
            for (int m = 0; m < 4; ++m) { float* rowp = base + (size_t)(row0 + ai * HALF + m * 16) * D + col0;
#pragma unroll
                for (int bj = 0; bj < 2; ++bj) { *(f32x4*)(rowp + bj * HALF) = acc[ai][bj][m][0]; *(f32x4*)(rowp + bj * HALF + 4) = acc[ai][bj][m][1]; } }
    }
};
struct EpiResid {
    const float* src_l; const float* src_c; float* dst_l; float* dst_c; const float* gate;
    DI void operator()(const f32x4 (&acc)[2][2][4][2], const Unit& u, int wr, int wc, int fr, int fq) const {
        const int trow = u.pm * BM; const bool lat = trow < ML;
        const float* src = lat ? src_l : src_c; float* dst = lat ? dst_l : dst_c;
        const int rbase = (lat ? trow : trow - ML) + wr * 64 + fr; const int grow = lat ? (trow >> 12) : 16;
        const float* gp = gate + (size_t)grow * 6144;
        const int col0 = u.pn * BM + wc * 32 + 8 * fq;
#pragma unroll
        for (int bj = 0; bj < 2; ++bj) {
            const int col = col0 + bj * HALF;
            const f32x4 g0 = *(const f32x4*)(gp + col), g1 = *(const f32x4*)(gp + col + 4);
#pragma unroll
            for (int ai = 0; ai < 2; ++ai)
#pragma unroll
                for (int m = 0; m < 4; ++m) { const size_t off = (size_t)(rbase + ai * HALF + m * 16) * D + col;
                    const f32x4 x0 = *(const f32x4*)(src + off), x1 = *(const f32x4*)(src + off + 4);
                    *(f32x4*)(dst + off) = x0 + g0 * acc[ai][bj][m][0]; *(f32x4*)(dst + off + 4) = x1 + g1 * acc[ai][bj][m][1]; }
        }
    }
};
struct EpiGlu {
    const float* src_l; const float* src_c; float* dst_l; float* dst_c; const float* gate;
    DI void operator()(const f32x4 (&acc)[2][2][4][2], const Unit& u, int wr, int wc, int fr, int fq) const {
        const int trow = u.pm * BM; const bool lat = trow < ML;
        const float* src = lat ? src_l : src_c; float* dst = lat ? dst_l : dst_c;
        const int rbase = (lat ? trow : trow - ML) + wr * 64 + fr; const int grow = lat ? (trow >> 12) : 16;
        const float* gp = gate + (size_t)grow * 6144;
        const int col0 = u.pn * BM + wc * 32 + 8 * fq;
#pragma unroll
        for (int bj = 0; bj < 2; ++bj) {
            const int col = (col0 + bj * HALF) >> 1;
            const f32x4 g0 = *(const f32x4*)(gp + col);
#pragma unroll
            for (int ai = 0; ai < 2; ++ai)
#pragma unroll
                for (int m = 0; m < 4; ++m) { const size_t off = (size_t)(rbase + ai * HALF + m * 16) * D + col;
                    const f32x4 x0 = *(const f32x4*)(src + off); const f32x4 za = acc[ai][bj][m][0], zb = acc[ai][bj][m][1]; f32x4 o;
#pragma unroll
                    for (int q = 0; q < 4; ++q) o[q] = za[q] / (1.f + __expf(-zb[q]));
                    *(f32x4*)(dst + off) = x0 + g0 * o; }
        }
    }
};
}

DI int map_col(int mode, int n) {
    if (mode == 0) return n;
    if (mode == 1) return n < 416 ? n : (n < 512 ? -1 : n - 96);
    const int q = n >> 3, i = n & 7; return i < 4 ? 4 * q + i : 1024 + 4 * q + (i - 4);
}
DI void xpose_item(const float* W, int ldw, int Ks, bf16_t* WT, int Kd, int Nd, int mode, const float* scale, LAS float* scr, int item, int lane) {
    const int nblk = Nd / 32, kb = item / nblk, nb = item % nblk, k0 = 64 * kb, n0 = 32 * nb;
    const int sc = map_col(mode, n0 + (lane & 31));
    float wv[32];
    const bool okc = sc >= 0; const int scc = okc ? sc : 0;
#pragma unroll
    for (int i = 0; i < 32; ++i) { const int kk = 2 * i + (lane >> 5), k = k0 + kk; const int kc = k < Ks ? k : Ks - 1;
        float v = W[(size_t)kc * ldw + scc]; if (scale) v *= scale[kc];
        wv[i] = (okc && k < Ks) ? v : 0.f; }
#pragma unroll
    for (int i = 0; i < 32; ++i) { const int kk = 2 * i + (lane >> 5); scr[kk * 33 + (lane & 31)] = wv[i]; }
    LDS_WAIT();
    const int c = lane & 7;
#pragma unroll
    for (int j = 0; j < 4; ++j) { const int n = (lane >> 3) + 8 * j; const LAS float* s = scr + (8 * c) * 33 + n;
        u32x4 o; o.x = pk2(s[0 * 33], s[1 * 33]); o.y = pk2(s[2 * 33], s[3 * 33]); o.z = pk2(s[4 * 33], s[5 * 33]); o.w = pk2(s[6 * 33], s[7 * 33]);
        *(u32x4*)(WT + (size_t)(n0 + n) * Kd + k0 + 8 * c) = o; }
    LDS_WAIT();
}

DI void phase0(const KArgs& a, LAS unsigned char* lds, int G, int bid, int tid, int wave, int lane) {
    unsigned char* ws = a.ws;
    {
        LAS float* scr = (LAS float*)(lds + wave * 8448);
        const int gw = bid * 8 + wave, NGW = G * 8;
        constexpr int I_W1 = 2048, I_W2 = 2048, I_WIN = 1280, I_WUQ = 96, I_WUKV = 128, I_WOUT = 512, I_WGLU = 1024;
        constexpr int TOT = 4 * I_W1 + 4 * I_W2 + 2 * (I_WIN + I_WUQ + I_WUKV + I_WOUT + I_WGLU);
        for (int it = gw; it < TOT; it += NGW) {
            int r = it;
            if (r < 4 * I_W1) { const int l = r / I_W1; xpose_item(a.in[8] + (size_t)l * D * FF, FF, D, (bf16_t*)(ws + OFF_W1T) + (size_t)l * FF * D, D, FF, 0, nullptr, scr, r % I_W1, lane); continue; } r -= 4 * I_W1;
            if (r < 4 * I_W2) { const int l = r / I_W2; xpose_item(a.in[9] + (size_t)l * FF * D, D, FF, (bf16_t*)(ws + OFF_W2T) + (size_t)l * D * FF, FF, D, 0, nullptr, scr, r % I_W2, lane); continue; } r -= 4 * I_W2;
            if (r < 2 * I_WIN) { const int e = r / I_WIN; xpose_item(a.in[10] + (size_t)e * D * 2464, 2464, D, (bf16_t*)(ws + OFF_WINT) + (size_t)e * ZW * D, D, ZW, 1, nullptr, scr, r % I_WIN, lane); continue; } r -= 2 * I_WIN;
            if (r < 2 * I_WUQ) { const int e = r / I_WUQ; xpose_item(a.in[12] + (size_t)e * 256 * 768, 768, 256, (bf16_t*)(ws + OFF_WUQT) + (size_t)e * 768 * 256, 256, 768, 0, a.in[11] + e * 256, scr, r % I_WUQ, lane); continue; } r -= 2 * I_WUQ;
            if (r < 2 * I_WUKV) { const int e = r / I_WUKV; xpose_item(a.in[14] + (size_t)e * 128 * 1024, 1024, 128, (bf16_t*)(ws + OFF_WUKVT) + (size_t)e * 1024 * 256, 256, 1024, 0, a.in[13] + e * 128, scr, r % I_WUKV, lane); continue; } r -= 2 * I_WUKV;
            if (r < 2 * I_WOUT) { const int e = r / I_WOUT; xpose_item(a.in[19] + (size_t)e * D * D, D, D, (bf16_t*)(ws + OFF_WOUTT) + (size_t)e * D * D, D, D, 0, nullptr, scr, r % I_WOUT, lane); continue; } r -= 2 * I_WOUT;
            { const int o = r / I_WGLU; xpose_item(a.in[35] + (size_t)o * D * 2048, 2048, D, (bf16_t*)(ws + OFF_WGLUT) + (size_t)o * 2048 * D, D, 2048, 2, nullptr, scr, r % I_WGLU, lane); }
        }
    }
    {
        const int gt = bid * NTHREADS + tid, GT = G * NTHREADS;
        f32x2* tabr = (f32x2*)(ws + OFF_TABR); f32x2* taba = (f32x2*)(ws + OFF_TABA);
        for (int i = gt; i < T * 32; i += GT) { const int n = i >> 5, f = i & 31;
            const float th = exp2f(-(float)f * (13.287712379549449f / 32.f));
            double rev = (double)n * (double)th * 0.15915494309189535; rev -= floor(rev);
            tabr[i] = (f32x2){cos_rev((float)rev), sin_rev((float)rev)}; }
        for (int i = gt; i < T * 16; i += GT) { const int n = i >> 4, f = i & 15;
            const float th = exp2f(-(float)(f & 7) * (13.287712379549449f / 8.f));
            const int pos = (f < 8) ? (n >> 6) : (n & 63);
            double rev = (double)pos * (double)th * 0.15915494309189535; rev -= floor(rev);
            taba[i] = (f32x2){cos_rev((float)rev), sin_rev((float)rev)}; }
    }
    __syncthreads();
    {
        LAS float* sc = (LAS float*)lds;
        LAS float* part = (LAS float*)(lds + 69632);
        float* mod = (float*)(ws + OFF_MOD);
        if (bid < 384) {
            for (int i = tid; i < 17 * 1024; i += NTHREADS) { const int r = i >> 10, k = i & 1023; const float v = r < 16 ? a.in[1][r * 1024 + k] : a.in[3][k]; sc[i] = v / (1.f + __expf(-v)); }
            __syncthreads();
            for (int item = bid; item < 384; item += G) {
                const int l = item / 96, j0 = (item % 96) * 64;
                const float* W = a.in[4] + (size_t)l * D * 6144 + j0 + lane;
                float acc[17];
#pragma unroll
                for (int r = 0; r < 17; ++r) acc[r] = 0.f;
#pragma unroll 4
                for (int k4 = wave * 128; k4 < wave * 128 + 128; k4 += 4) {
                    const float w0 = W[(size_t)k4 * 6144], w1 = W[(size_t)(k4 + 1) * 6144], w2 = W[(size_t)(k4 + 2) * 6144], w3 = W[(size_t)(k4 + 3) * 6144];
#pragma unroll
                    for (int r = 0; r < 17; ++r) { const f32x4 s = *(const LAS f32x4*)(sc + r * 1024 + k4); acc[r] += s[0] * w0 + s[1] * w1 + s[2] * w2 + s[3] * w3; }
                }
#pragma unroll
                for (int r = 0; r < 17; ++r) part[(wave * 17 + r) * 64 + lane] = acc[r];
                __syncthreads();
                for (int i = tid; i < 17 * 64; i += NTHREADS) { const int r = i >> 6, j = i & 63; float s = a.in[5][l * 6144 + j0 + j];
#pragma unroll
                    for (int w = 0; w < 8; ++w) s += part[(w * 17 + r) * 64 + j];
                    mod[(size_t)(l * 17 + r) * 6144 + j0 + j] = s; }
                __syncthreads();
            }
        }
    }
}

DI void normmod_phase(const float* xl, const float* xc, const float* g, const float* modl  , int cshift, int cscale, bf16_t* H, int nrows, int gw, int NGW, int lane,
                      const float* part  , const float* pgate  , float* xc_out) {
    auto ld = [&](const int row, f32x4 (&v)[4]) __attribute__((always_inline)) -> float {
        const bool lat = row < ML;
        const float* xr = lat ? xl + (size_t)row * D : xc + (size_t)(row - ML) * D;
        float ss = 0.f;
#pragma unroll
        for (int j = 0; j < 4; ++j) { v[j] = *(const f32x4*)(xr + lane * 4 + 256 * j);
            if (part && !lat) {
                const size_t po = (size_t)(row - ML) * D + lane * 4 + 256 * j;
                const f32x4 p0 = *(const f32x4*)(part + po), p1 = *(const f32x4*)(part + (size_t)MC * D + po), p2 = *(const f32x4*)(part + (size_t)2 * MC * D + po), p3 = *(const f32x4*)(part + (size_t)3 * MC * D + po);
                v[j] = v[j] + *(const f32x4*)(pgate + lane * 4 + 256 * j) * ((p0 + p1) + (p2 + p3));
                *(f32x4*)(xc_out + po) = v[j]; }
            ss += (v[j][0] * v[j][0] + v[j][1] * v[j][1]) + (v[j][2] * v[j][2] + v[j][3] * v[j][3]); }
        return ss; };
    auto st = [&](const int row, const f32x4 (&v)[4], const float rs) __attribute__((always_inline)) {
        const float* mp = modl + (size_t)((row < ML) ? (row >> 12) : 16) * 6144;
#pragma unroll
        for (int j = 0; j < 4; ++j) { const int c = lane * 4 + 256 * j;
            const f32x4 gg = *(const f32x4*)(g + c), sh = *(const f32x4*)(mp + cshift * 1024 + c), scl = *(const f32x4*)(mp + cscale * 1024 + c);
            const f32x4 y = (v[j] * rs) * gg * (scl + 1.f) + sh;
            u32x2 o; o.x = pk2(y[0], y[1]); o.y = pk2(y[2], y[3]);
            *(u32x2*)(H + (size_t)row * D + c) = o; } };
    for (int row = gw * 4; row < (nrows < ML ? nrows : ML); row += NGW * 4) {
        f32x4 vA[4], vB[4], vC[4], vD[4];
        float sA = ld(row, vA), sB = ld(row + 1, vB), sC = ld(row + 2, vC), sD = ld(row + 3, vD);
#pragma unroll
        for (int o = 1; o < 64; o <<= 1) { sA += __shfl_xor(sA, o); sB += __shfl_xor(sB, o); sC += __shfl_xor(sC, o); sD += __shfl_xor(sD, o); }
        st(row, vA, rsqrtf(sA * (1.f / D) + EPS)); st(row + 1, vB, rsqrtf(sB * (1.f / D) + EPS));
        st(row + 2, vC, rsqrtf(sC * (1.f / D) + EPS)); st(row + 3, vD, rsqrtf(sD * (1.f / D) + EPS));
    }
    for (int row = ML + gw * 2; row < nrows; row += NGW * 2) {
        f32x4 vA[4], vB[4];
        float sA = ld(row, vA), sB = ld(row + 1, vB);
#pragma unroll
        for (int o = 1; o < 64; o <<= 1) { sA += __shfl_xor(sA, o); sB += __shfl_xor(sB, o); }
        st(row, vA, rsqrtf(sA * (1.f / D) + EPS)); st(row + 1, vB, rsqrtf(sB * (1.f / D) + EPS));
    }
}

DI void prep_phase(const KArgs& a, int zz, int e, const bf16_t* Z, const bf16_t* QP, const bf16_t* KVP, bf16_t* Qb, bf16_t* Kb, bf16_t* VT, LAS unsigned char* lds, int G, int bid, int tid, int wave, int lane) {
    const f32x2* taba = (const f32x2*)(a.ws + zz + OFF_TABA);
    const float* qn_g = a.in[zz + 15] + e * 96; const float* kn_g = a.in[zz + 16] + e * 96;
    const int gt = bid * NTHREADS + tid, GT = G * NTHREADS;
    for (int gidx = gt; gidx < M * 8; gidx += GT) {
        const int row = gidx >> 3, h = gidx & 7;
        const bool lat = row < ML; int b, pos, t = 0;
        if (lat) { b = row >> 12; t = row & 4095; pos = TC + t; } else { const int rc = row - ML; b = rc >> 8; pos = rc & 255; }
        const bf16_t* zr = Z + (size_t)row * ZW;
        float f[8];
        float ss = 0.f;
#pragma unroll
        for (int i = 0; i < 4; ++i) { unpack8(*(const u32x4*)(zr + h * 32 + i * 8), f);
#pragma unroll
            for (int q = 0; q < 8; ++q) ss += f[q] * f[q]; }
        ss += __shfl_xor(ss, 1); ss += __shfl_xor(ss, 2); ss += __shfl_xor(ss, 4);
        const float rs_q = rsqrtf(ss * (1.f / 256.f) + EPS);
        ss = 0.f;
#pragma unroll
        for (int i = 0; i < 2; ++i) { unpack8(*(const u32x4*)(zr + 256 + h * 16 + i * 8), f);
#pragma unroll
            for (int q = 0; q < 8; ++q) ss += f[q] * f[q]; }
        ss += __shfl_xor(ss, 1); ss += __shfl_xor(ss, 2); ss += __shfl_xor(ss, 4);
        const float rs_kv = rsqrtf(ss * (1.f / 128.f) + EPS);
        {
            const bf16_t* src = QP + (size_t)row * 768 + h * 96;
            bf16_t* dst = Qb + ((size_t)(b * 8 + h) * TK + pos) * 96;
            u32x4 qr[12];
#pragma unroll
            for (int i = 0; i < 12; ++i) qr[i] = *(const u32x4*)(src + i * 8);
            float s2 = 0.f;
#pragma unroll
            for (int i = 0; i < 12; ++i) { unpack8(qr[i], f);
#pragma unroll
                for (int q = 0; q < 8; ++q) { const float v = f[q] * rs_q; s2 += v * v; } }
            const float fs = rs_q * rsqrtf(s2 * (1.f / 96.f) + EPS);
#pragma unroll
            for (int i = 0; i < 8; ++i) { unpack8(qr[i], f); float o[8];
#pragma unroll
                for (int q = 0; q < 8; ++q) o[q] = f[q] * fs * qn_g[i * 8 + q] * QSCALE;
                *(u32x4*)(dst + i * 8) = pack8(o); }
#pragma unroll
            for (int i = 0; i < 2; ++i) { float f2[8], o1[8], o2[8]; unpack8(qr[8 + i], f); unpack8(qr[10 + i], f2);
#pragma unroll
                for (int q = 0; q < 8; ++q) { const float x1 = f[q] * fs * qn_g[64 + i * 8 + q], x2 = f2[q] * fs * qn_g[80 + i * 8 + q];
                    float c = 1.f, s = 0.f; if (lat) { const f32x2 cs = taba[t * 16 + i * 8 + q]; c = cs[0]; s = cs[1]; }
                    o1[q] = (x1 * c - x2 * s) * QSCALE; o2[q] = (x1 * s + x2 * c) * QSCALE; }
                *(u32x4*)(dst + 64 + i * 8) = pack8(o1); *(u32x4*)(dst + 80 + i * 8) = pack8(o2); }
        }
        {
            const bf16_t* src = KVP + (size_t)row * 1024 + h * 128;
            const bf16_t* kr = zr + 384;
            bf16_t* dst = Kb + ((size_t)(b * 8 + h) * TK + pos) * 96;
            u32x4 kn[8], kq[4];
#pragma unroll
            for (int i = 0; i < 8; ++i) kn[i] = *(const u32x4*)(src + i * 8);
#pragma unroll
            for (int i = 0; i < 4; ++i) kq[i] = *(const u32x4*)(kr + i * 8);
            float s2 = 0.f;
#pragma unroll
            for (int i = 0; i < 8; ++i) { unpack8(kn[i], f);
#pragma unroll
                for (int q = 0; q < 8; ++q) { const float v = f[q] * rs_kv; s2 += v * v; } }
#pragma unroll
            for (int i = 0; i < 4; ++i) { unpack8(kq[i], f);
#pragma unroll
                for (int q = 0; q < 8; ++q) s2 += f[q] * f[q]; }
            const float ks = rsqrtf(s2 * (1.f / 96.f) + EPS);
            const float fs = rs_kv * ks;
#pragma unroll
            for (int i = 0; i < 8; ++i) { unpack8(kn[i], f); float o[8];
#pragma unroll
                for (int q = 0; q < 8; ++q) o[q] = f[q] * fs * kn_g[i * 8 + q];
                *(u32x4*)(dst + i * 8) = pack8(o); }
#pragma unroll
            for (int i = 0; i < 2; ++i) { float f2[8], o1[8], o2[8]; unpack8(kq[i], f); unpack8(kq[2 + i], f2);
#pragma unroll
                for (int q = 0; q < 8; ++q) { const float x1 = f[q] * ks * kn_g[64 + i * 8 + q], x2 = f2[q] * ks * kn_g[80 + i * 8 + q];
                    float c = 1.f, s = 0.f; if (lat) { const f32x2 cs = taba[t * 16 + i * 8 + q]; c = cs[0]; s = cs[1]; }
                    o1[q] = x1 * c - x2 * s; o2[q] = x1 * s + x2 * c; }
                *(u32x4*)(dst + 64 + i * 8) = pack8(o1); *(u32x4*)(dst + 80 + i * 8) = pack8(o2); }
        }
    }
    {
        const int gw = bid * 8 + wave, NGW = G * 8;
        LAS bf16_t* tl = (LAS bf16_t*)(lds + wave * 8704);
        for (int u = gw; u < (M / 64) * 2; u += NGW) {
            const int rb = u >> 1, hh = (u & 1) * 4; const int row = rb * 64 + lane, rowb = rb * 64;
            int b, posb;
            if (rowb < ML) { b = rowb >> 12; posb = TC + (rowb & 4095); } else { const int rc = rowb - ML; b = rc >> 8; posb = rc & 255; }
            const bf16_t* zr = Z + (size_t)row * ZW + 256;
            float f[8]; float ss = 0.f;
#pragma unroll
            for (int i = 0; i < 16; ++i) { unpack8(*(const u32x4*)(zr + i * 8), f);
#pragma unroll
                for (int q = 0; q < 8; ++q) ss += f[q] * f[q]; }
            const float rs_kv = rsqrtf(ss * (1.f / 128.f) + EPS);
            for (int h = hh; h < hh + 4; ++h) {
                const bf16_t* src = KVP + (size_t)row * 1024 + h * 128 + 64;
#pragma unroll
                for (int ch = 0; ch < 8; ++ch) { unpack8(*(const u32x4*)(src + ch * 8), f);
#pragma unroll
                    for (int q = 0; q < 8; ++q) f[q] *= rs_kv;
                    const u32x4 w = pack8(f);
                    *(LAS u32x2*)(tl + lane * 68 + ch * 8) = (u32x2){w.x, w.y}; *(LAS u32x2*)(tl + lane * 68 + ch * 8 + 4) = (u32x2){w.z, w.w}; }
                LDS_WAIT();
                bf16_t* dst = VT + ((size_t)(b * 8 + h) * 64 + lane) * TK + posb;
#pragma unroll
                for (int c = 0; c < 8; ++c) { const int base = (c >> 1) * 16 + (c & 1) * 4; unsigned v[8];
#pragma unroll
                    for (int k = 0; k < 8; ++k) v[k] = tl[(base + (k & 3) + (k >> 2) * 8) * 68 + lane];
                    u32x4 o; o.x = v[0] | (v[1] << 16); o.y = v[2] | (v[3] << 16); o.z = v[4] | (v[5] << 16); o.w = v[6] | (v[7] << 16);
                    *(u32x4*)(dst + c * 8) = o; }
                LDS_WAIT();
            }
        }
    }
}

constexpr int AT_KB = 64 * 104 * 2, AT_VB = 64 * 72 * 2;
DI int crow(int r, int hi) { return (r & 3) + 8 * (r >> 2) + 4 * hi; }
DI void attn_phase(const bf16_t* Qb, const bf16_t* Kb, const bf16_t* VT, bf16_t* MIX, LAS unsigned char* lds, int G, int bid, int tid, int wave, int lane) {
    const int r32 = lane & 31, hi = lane >> 5;
    LAS float* scrw = (LAS float*)(lds + 2 * AT_KB + 2 * AT_VB) + wave * 64;
    constexpr int NU_LAT = NB * 8 * 16, NU = NU_LAT + NB * 8;
    const int vcu = ((G & 7) == 0) ? (bid & 7) * (G >> 3) + (bid >> 3) : bid;
    const int kc0 = tid, kc1 = 512 + tid, kc1c = 512 + (tid & 255);
    const int kl0 = (kc0 / 12) * 208 + (kc0 % 12) * 16, kl1 = (kc1 / 12) * 208 + (kc1 % 12) * 16;
    const int vd = tid >> 3, vch = tid & 7; const int vl = vd * 144 + vch * 16;
    for (int u = vcu; u < NU; u += G) {
        int bh, qpos0, nt; size_t orow0;
        if (u < NU_LAT) { bh = u >> 4; const int qb = u & 15; qpos0 = TC + qb * 256; nt = TK / 64; orow0 = (size_t)(bh >> 3) * T + qb * 256; }
        else { bh = u - NU_LAT; qpos0 = 0; nt = TC / 64; orow0 = (size_t)ML + (size_t)(bh >> 3) * TC; }
        const int h = bh & 7;
        const bf16_t* Kh = Kb + (size_t)bh * TK * 96; const bf16_t* Vh = VT + (size_t)bh * 64 * TK;
        bf16x8 qf[6];
        { const bf16_t* qp = Qb + ((size_t)bh * TK + qpos0 + wave * 32 + r32) * 96 + hi * 8;
#pragma unroll
          for (int d0 = 0; d0 < 6; ++d0) qf[d0] = *(const bf16x8*)(qp + d0 * 16); }
        u32x4 rkA0, rkA1, rvA, rkB0, rkB1, rvB;
#define AT_LOAD(S, kt, vt) do { const int kt_ = (kt) < nt ? (kt) : nt - 1, vt_ = (vt) < nt ? (vt) : nt - 1; const bf16_t* Kt_ = Kh + (size_t)kt_ * 64 * 96; \
        rk##S##0 = *(const u32x4*)(Kt_ + kc0 * 8); rk##S##1 = *(const u32x4*)(Kt_ + kc1c * 8); rv##S = *(const u32x4*)(Vh + (size_t)vd * TK + vt_ * 64 + vch * 8); } while (0)
#define AT_STOREK(S, bb) do { LAS unsigned char* Kn_ = lds + (bb) * AT_KB; *(LAS u32x4*)(Kn_ + kl0) = rk##S##0; if (tid < 256) *(LAS u32x4*)(Kn_ + kl1) = rk##S##1; } while (0)
#define AT_STOREV(S, bb) do { *(LAS u32x4*)(lds + 2 * AT_KB + (bb) * AT_VB + vl) = rv##S; } while (0)
        float lsum = 0.f;
        f32x16 o0, o1, sA0, sA1, sB0, sB1;
#pragma unroll
        for (int r = 0; r < 16; ++r) { o0[r] = 0.f; o1[r] = 0.f; }
        auto qk = [&](f32x16& s0, f32x16& s1, const int kbuf) __attribute__((always_inline)) {
            const LAS unsigned char* Kl = lds + kbuf * AT_KB;
            f32x16 z;
#pragma unroll
            for (int r = 0; r < 16; ++r) z[r] = 0.f;
#pragma unroll
            for (int d0 = 0; d0 < 6; ++d0) {
                const bf16x8 a0 = *(const LAS bf16x8*)(Kl + r32 * 208 + d0 * 32 + hi * 16);
                const bf16x8 a1 = *(const LAS bf16x8*)(Kl + (32 + r32) * 208 + d0 * 32 + hi * 16);
                if (d0 == 0) { s0 = MFMA32(a0, qf[0], z); s1 = MFMA32(a1, qf[0], z); }
                else { s0 = MFMA32(a0, qf[d0], s0); s1 = MFMA32(a1, qf[d0], s1); }
            }
        };
        auto softmax_pack = [&](f32x16& s0, f32x16& s1, bf16x8 (&pa)[4]) __attribute__((always_inline)) {
            float ps0 = 0.f, ps1 = 0.f;
#pragma unroll
            for (int r = 0; r < 16; ++r) { s0[r] = __builtin_amdgcn_exp2f(s0[r]); s1[r] = __builtin_amdgcn_exp2f(s1[r]); ps0 += s0[r]; ps1 += s1[r]; }
            lsum += ps0 + ps1;
            u32x4 w;
            w.x = pk2(s0[0], s0[1]); w.y = pk2(s0[2], s0[3]); w.z = pk2(s0[4], s0[5]); w.w = pk2(s0[6], s0[7]); pa[0] = __builtin_bit_cast(bf16x8, w);
            w.x = pk2(s0[8], s0[9]); w.y = pk2(s0[10], s0[11]); w.z = pk2(s0[12], s0[13]); w.w = pk2(s0[14], s0[15]); pa[1] = __builtin_bit_cast(bf16x8, w);
            w.x = pk2(s1[0], s1[1]); w.y = pk2(s1[2], s1[3]); w.z = pk2(s1[4], s1[5]); w.w = pk2(s1[6], s1[7]); pa[2] = __builtin_bit_cast(bf16x8, w);
            w.x = pk2(s1[8], s1[9]); w.y = pk2(s1[10], s1[11]); w.z = pk2(s1[12], s1[13]); w.w = pk2(s1[14], s1[15]); pa[3] = __builtin_bit_cast(bf16x8, w);
        };
        auto pv = [&](const bf16x8 (&pa)[4], const int vbuf) __attribute__((always_inline)) {
            const LAS unsigned char* Vl = lds + 2 * AT_KB + vbuf * AT_VB;
#pragma unroll
            for (int kk = 0; kk < 4; ++kk) {
                const LAS unsigned char* vp = Vl + r32 * 144 + kk * 32 + hi * 16;
                const bf16x8 b0 = *(const LAS bf16x8*)(vp);
                const bf16x8 b1 = *(const LAS bf16x8*)(vp + 32 * 144);
                o0 = MFMA32(pa[kk], b0, o0); o1 = MFMA32(pa[kk], b1, o1);
            }
        };
        AT_LOAD(A, 0, 0); AT_LOAD(B, 1, 1);
        AT_STOREK(A, 0); AT_STOREV(A, 0); AT_STOREK(B, 1);
        AT_LOAD(B, 2, 1);
        __syncthreads();
        qk(sA0, sA1, 0);
        __syncthreads();
#define AT_STEP(sc0, sc1, sn0, sn1, tt, par, LS, SS) do { \
            AT_LOAD(LS, (tt) + 3, (tt) + 2); \
            bf16x8 pa_[4]; \
            qk(sn0, sn1, (par) ^ 1); \
            softmax_pack(sc0, sc1, pa_); \
            pv(pa_, (par)); \
            AT_STOREK(SS, (par)); AT_STOREV(SS, (par) ^ 1); \
            __syncthreads(); } while (0)
        int t = 0;
        for (; t + 2 < nt; t += 2) { AT_STEP(sA0, sA1, sB0, sB1, t, 0, A, B); AT_STEP(sB0, sB1, sA0, sA1, t + 1, 1, B, A); }
        AT_STEP(sA0, sA1, sB0, sB1, t, 0, A, B);
        { bf16x8 pa_[4]; softmax_pack(sB0, sB1, pa_); pv(pa_, 1); }
#undef AT_STEP
#undef AT_LOAD
#undef AT_STOREK
#undef AT_STOREV
        lsum += __shfl_xor(lsum, 32);
        scrw[r32] = __builtin_amdgcn_rcpf(lsum);
        LDS_WAIT();
        bf16_t* op = MIX + (orow0 + wave * 32) * D + h * 64 + r32;
#pragma unroll
        for (int r = 0; r < 16; ++r) { const int q = crow(r, hi); const float il = scrw[q];
            op[(size_t)q * D] = f2bf(o0[r] * il); op[(size_t)q * D + 32] = f2bf(o1[r] * il); }
        LDS_WAIT();
        __syncthreads();
    }
}

constexpr int RT_Q = 0, RT_K = 18432, RT_KT = 36864, RT_VT = 54272, RT_ST = 71680;
DI void ret_phase(const KArgs& a, int zz, int e, const bf16_t* Z, bf16_t* OF, bf16_t* OB, LAS unsigned char* lds, int G, int bid, int tid, int wave, int lane) {
    const f32x2* tabr = (const f32x2*)(a.ws + zz + OFF_TABR);
    const int fr = lane & 15, fq = lane >> 4;
    LAS bf16_t* Qs = (LAS bf16_t*)(lds + RT_Q); LAS bf16_t* Ks = (LAS bf16_t*)(lds + RT_K); LAS bf16_t* KTs = (LAS bf16_t*)(lds + RT_KT);
    LAS bf16_t* VTs = (LAS bf16_t*)(lds + RT_VT); LAS bf16_t* STs = (LAS bf16_t*)(lds + RT_ST);
    for (int u = bid; u < NB * 8 * 2; u += G) {
        const int dir = u & 1, h = (u >> 1) & 7, b = u >> 4;
        bf16_t* O = dir ? OB : OF;
        const float raw = a.in[zz + (dir ? 18 : 17)][e * 8 + h];
        const float lg2 = log1pf(-exp2f(raw)) * LOG2E;
        const float cd = exp2f(128.f * lg2);
        for (int i = tid; i < 64 * 72 / 2; i += NTHREADS) ((LAS unsigned*)STs)[i] = 0u;
        f32x4 sacc[2]; sacc[0] = (f32x4){0.f, 0.f, 0.f, 0.f}; sacc[1] = (f32x4){0.f, 0.f, 0.f, 0.f};
        const int et_s = wave >> 1, dt0 = (wave & 1) * 2;
        __syncthreads();
        u32x4 fq1_, fq2_, fk1_, fk2_, fv1_, fv2_;
        auto chunk_row0 = [&](const int ci, int& t0o, bool& sego) __attribute__((always_inline)) -> size_t {
            const int cc = ci < 34 ? ci : 33; const bool seg = cc < 2; const int k = seg ? cc : cc - 2, nch = seg ? 2 : 32, cidx = dir ? nch - 1 - k : k;
            t0o = cidx * 128; sego = seg;
            return seg ? (size_t)ML + b * TC + cidx * 128 : (size_t)b * T + cidx * 128; };
        auto issue = [&](const int ci) __attribute__((always_inline)) {
            int t0d; bool sd; const size_t r0 = chunk_row0(ci, t0d, sd);
            const bf16_t* zr = Z + (r0 + (tid >> 2)) * ZW + h * 64; const int c = tid & 3;
            fq1_ = *(const u32x4*)(zr + 512 + c * 8); fq2_ = *(const u32x4*)(zr + 512 + 32 + c * 8);
            fk1_ = *(const u32x4*)(zr + 1024 + c * 8); fk2_ = *(const u32x4*)(zr + 1024 + 32 + c * 8);
            fv1_ = *(const u32x4*)(zr + 1536 + c * 16); fv2_ = *(const u32x4*)(zr + 1536 + c * 16 + 8); };
        issue(0);
        for (int ci = 0; ci < 34; ++ci) {
            int t0; bool seg; const size_t row0 = chunk_row0(ci, t0, seg);
            {
                const int r = tid >> 2, c = tid & 3;
                float x1[8], x2[8], o1[8], o2[8];
                unpack8(fq1_, x1); unpack8(fq2_, x2);
                f32x2 cs[8];
#pragma unroll
                for (int i = 0; i < 8; ++i) cs[i] = seg ? (f32x2){1.f, 0.f} : tabr[(size_t)(t0 + r) * 32 + c * 8 + i];
#pragma unroll
                for (int i = 0; i < 8; ++i) { o1[i] = x1[i] * cs[i][0] - x2[i] * cs[i][1]; o2[i] = x1[i] * cs[i][1] + x2[i] * cs[i][0]; }
                *(LAS u32x4*)(Qs + r * 72 + c * 8) = pack8(o1); *(LAS u32x4*)(Qs + r * 72 + 32 + c * 8) = pack8(o2);
                unpack8(fk1_, x1); unpack8(fk2_, x2);
#pragma unroll
                for (int i = 0; i < 8; ++i) { o1[i] = (x1[i] * cs[i][0] - x2[i] * cs[i][1]) * 0.125f; o2[i] = (x1[i] * cs[i][1] + x2[i] * cs[i][0]) * 0.125f; }
                *(LAS u32x4*)(Ks + r * 72 + c * 8) = pack8(o1); *(LAS u32x4*)(Ks + r * 72 + 32 + c * 8) = pack8(o2);
                const float kd = __builtin_amdgcn_exp2f((float)(dir ? r : 127 - r) * lg2);
#pragma unroll
                for (int i = 0; i < 8; ++i) { KTs[(c * 8 + i) * 136 + r] = f2bf(o1[i] * kd); KTs[(32 + c * 8 + i) * 136 + r] = f2bf(o2[i] * kd); }
                unpack8(fv1_, x1); unpack8(fv2_, x2);
#pragma unroll
                for (int i = 0; i < 8; ++i) { VTs[(c * 16 + i) * 136 + r] = f2bf(x1[i]); VTs[(c * 16 + 8 + i) * 136 + r] = f2bf(x2[i]); }
            }
            __syncthreads();
            issue(ci + 1);
            {
                const int il = 16 * wave + fr;
                bf16x8 Qf[2];
#pragma unroll
                for (int ks = 0; ks < 2; ++ks) Qf[ks] = *(const LAS bf16x8*)(Qs + il * 72 + ks * 32 + fq * 8);
                f32x4 st[8];
#pragma unroll
                for (int jt = 0; jt < 8; ++jt) { st[jt] = (f32x4){0.f, 0.f, 0.f, 0.f};
#pragma unroll
                    for (int ks = 0; ks < 2; ++ks) { const bf16x8 A = *(const LAS bf16x8*)(Ks + (16 * jt + fr) * 72 + ks * 32 + fq * 8); st[jt] = MFMA16(A, Qf[ks], st[jt]); } }
                bf16x8 Pf[4];
#pragma unroll
                for (int kk = 0; kk < 4; ++kk) { float p[8];
#pragma unroll
                    for (int q = 0; q < 8; ++q) { const int jt = 2 * kk + (q >> 2), jj = q & 3; const int j = 16 * jt + fq * 4 + jj;
                        const int diff = dir ? j - il : il - j; const bool valid = dir ? diff > 0 : diff >= 0;
                        p[q] = valid ? st[jt][jj] * __builtin_amdgcn_exp2f((float)diff * lg2) : 0.f; }
                    Pf[kk] = __builtin_bit_cast(bf16x8, pack8(p)); }
                const float qd = __builtin_amdgcn_exp2f((float)(dir ? 128 - il : il + 1) * lg2);
#pragma unroll
                for (int et = 0; et < 4; ++et) {
                    f32x4 oa = (f32x4){0.f, 0.f, 0.f, 0.f}, o2 = (f32x4){0.f, 0.f, 0.f, 0.f};
#pragma unroll
                    for (int kk = 0; kk < 4; ++kk) { const LAS bf16_t* vp = VTs + (16 * et + fr) * 136 + 32 * kk + fq * 4;
                        const s16x4 lo = *(const LAS s16x4*)(vp), hi4 = *(const LAS s16x4*)(vp + 16);
                        const bf16x8 A = __builtin_shufflevector(lo, hi4, 0, 1, 2, 3, 4, 5, 6, 7);
                        oa = MFMA16(A, Pf[kk], oa); }
#pragma unroll
                    for (int ks = 0; ks < 2; ++ks) { const bf16x8 A = *(const LAS bf16x8*)(STs + (16 * et + fr) * 72 + ks * 32 + fq * 8); o2 = MFMA16(A, Qf[ks], o2); }
                    const f32x4 ov = oa + o2 * qd;
                    u32x2 w; w.x = pk2(ov[0], ov[1]); w.y = pk2(ov[2], ov[3]);
                    *(u32x2*)(O + (row0 + il) * 512 + h * 64 + 16 * et + fq * 4) = w;
                }
#pragma unroll
                for (int q = 0; q < 2; ++q) { const int dt = dt0 + q; sacc[q] = sacc[q] * cd;
#pragma unroll
                    for (int kk = 0; kk < 4; ++kk) { const bf16x8 A = *(const LAS bf16x8*)(VTs + (16 * et_s + fr) * 136 + 32 * kk + fq * 8);
                        const bf16x8 B = *(const LAS bf16x8*)(KTs + (16 * dt + fr) * 136 + 32 * kk + fq * 8); sacc[q] = MFMA16(A, B, sacc[q]); } }
            }
            __syncthreads();
#pragma unroll
            for (int q = 0; q < 2; ++q)
#pragma unroll
                for (int jj = 0; jj < 4; ++jj) STs[(16 * et_s + fq * 4 + jj) * 72 + 16 * (dt0 + q) + fr] = f2bf(sacc[q][jj]);
        }
        __syncthreads();
    }
}

DI void retcomb_phase(const bf16_t* Z, const bf16_t* OF, const bf16_t* OB, bf16_t* MIX, int gw, int NGW, int lane) {
    for (int row = gw; row < M; row += NGW) {
        float f1[8], f2[8], g[8], o[8];
        unpack8(*(const u32x4*)(OF + (size_t)row * 512 + lane * 8), f1); unpack8(*(const u32x4*)(OB + (size_t)row * 512 + lane * 8), f2);
        unpack8(*(const u32x4*)(Z + (size_t)row * ZW + 2048 + lane * 8), g);
        float s = 0.f;
#pragma unroll
        for (int q = 0; q < 8; ++q) { o[q] = f1[q] + f2[q]; s += o[q]; }
        s += __shfl_xor(s, 1); s += __shfl_xor(s, 2); s += __shfl_xor(s, 4);
        const float mu = s * (1.f / 64.f); float v = 0.f;
#pragma unroll
        for (int q = 0; q < 8; ++q) { o[q] -= mu; v += o[q] * o[q]; }
        v += __shfl_xor(v, 1); v += __shfl_xor(v, 2); v += __shfl_xor(v, 4);
        const float rs = rsqrtf(v * (1.f / 64.f) + EPS);
#pragma unroll
        for (int q = 0; q < 8; ++q) o[q] = o[q] * rs * (g[q] / (1.f + __expf(-g[q])));
        *(u32x4*)(MIX + (size_t)row * D + 512 + lane * 8) = pack8(o);
    }
}

DI void s5_phase(const KArgs& a, int zz, int o, const bf16_t* H, bf16_t* YF, bf16_t* YB, LAS unsigned char* lds, int G, int bid, int wave, int lane) {
    const int fr = lane & 15, fq = lane >> 4;
    LAS float* BU = (LAS float*)(lds + wave * 12800);
    LAS unsigned* XS = (LAS unsigned*)(lds + wave * 12800 + 8448);
    for (int u = bid; u < NB * 16; u += G) {
        const int b = u >> 4, g = (u & 15) * 4 + (wave >> 1), dir = wave & 1;
        const int pb = zz + (dir ? 27 : 20);
        const float* are = a.in[pb + 0] + (size_t)(o * 64 + g) * 64; const float* aim = a.in[pb + 1] + (size_t)(o * 64 + g) * 64;
        const float* bre = a.in[pb + 2] + (size_t)(o * 64 + g) * 64 * 16; const float* bim = a.in[pb + 3] + (size_t)(o * 64 + g) * 64 * 16;
        const float* cre = a.in[pb + 4] + (size_t)(o * 64 + g) * 16 * 64; const float* cim = a.in[pb + 5] + (size_t)(o * 64 + g) * 16 * 64;
        const float dt = __expf(a.in[pb + 6][o * 64 + g]);
        bf16_t* Y = dir ? YB : YF;
        float abr, abi;
        { const float ar = are[lane], ai = aim[lane]; const float mag = __expf(dt * ar); float rev = dt * ai * 0.15915494309189535f; rev -= floorf(rev);
          abr = mag * cos_rev(rev); abi = mag * sin_rev(rev); }
        bf16x8 Bb[8];
#pragma unroll
        for (int nt = 0; nt < 8; ++nt) {
            const int c = 16 * nt + fr, p2 = c >> 1, part = c & 1;
            const float ar = are[p2], ai = aim[p2]; const float mag = __expf(dt * ar); float rev = dt * ai * 0.15915494309189535f; rev -= floorf(rev);
            const float er = mag * cos_rev(rev) - 1.f, ei = mag * sin_rev(rev); const float den = 1.f / (ar * ar + ai * ai);
            const float cr = (er * ar + ei * ai) * den, ci = (ei * ar - er * ai) * den;
            float v[8];
#pragma unroll
            for (int j = 0; j < 8; ++j) v[j] = 0.f;
            if (fq < 2) {
#pragma unroll
                for (int j = 0; j < 8; ++j) { const float br = bre[p2 * 16 + fq * 8 + j], bi = bim[p2 * 16 + fq * 8 + j]; v[j] = part ? (cr * bi + ci * br) : (cr * br - ci * bi); } }
            Bb[nt] = __builtin_bit_cast(bf16x8, pack8(v));
        }
        bf16x8 Cb[4];
#pragma unroll
        for (int kb = 0; kb < 4; ++kb) { float v[8];
#pragma unroll
            for (int j = 0; j < 8; ++j) { const int p3 = kb * 16 + fq * 4 + (j >> 1); v[j] = (j & 1) ? -cim[fr * 64 + p3] : cre[fr * 64 + p3]; }
            Cb[kb] = __builtin_bit_cast(bf16x8, pack8(v)); }
        auto run_dir = [&](auto dirc) __attribute__((always_inline)) {
        constexpr bool DIRC = decltype(dirc)::value;
        float xr = 0.f, xi = 0.f; const float nabi = -abi;
        const bf16_t* Hg = H + g * 16 + (fq & 1) * 8;
        auto chunk_row = [&](int ci) -> size_t { const bool seg = ci < 16; const int k = seg ? ci : ci - 16, nch = seg ? 16 : 256, cidx = DIRC ? nch - 1 - k : k;
            return seg ? (size_t)ML + b * TC + cidx * 16 : (size_t)b * T + cidx * 16; };
#define S5_CB() asm volatile("" ::: "memory")
        auto loadu = [&](const int ci) __attribute__((always_inline)) -> u32x4 {
            const int cc = ci < 272 ? ci : 271;
            u32x4 r = *(const u32x4*)(Hg + (chunk_row(cc) + fr) * D);
            const bool keep = fq < 2;
            r.x = keep ? r.x : 0u; r.y = keep ? r.y : 0u; r.z = keep ? r.z : 0u; r.w = keep ? r.w : 0u;
            return r; };
        auto stageA = [&](const u32x4 uu) __attribute__((always_inline)) {
            const bf16x8 Au = __builtin_bit_cast(bf16x8, uu);
#pragma unroll
            for (int nt = 0; nt < 8; ++nt) { const f32x4 acc = MFMA16(Bb[nt], Au, ((f32x4){0.f, 0.f, 0.f, 0.f}));
                *(LAS f32x4*)(BU + fr * 132 + 16 * nt + fq * 4) = acc; } };
        u32x4 u1 = loadu(1), u2 = loadu(2);
        stageA(loadu(0));
        S5_CB();
        size_t rowprev = 0;
        auto iter = [&](const int ci, const bool do_c) __attribute__((always_inline)) {
            const size_t row0 = chunk_row(ci);
            const u32x4 u3 = loadu(ci + 3);
            f32x2 bu[16];
#pragma unroll
            for (int s = 0; s < 16; ++s) { const int tt = DIRC ? 15 - s : s; bu[s] = *(const LAS f32x2*)(BU + tt * 132 + 2 * lane); }
            bf16x8 Ax[4];
            if (do_c) {
#pragma unroll
                for (int kb = 0; kb < 4; ++kb) Ax[kb] = *(const LAS bf16x8*)(XS + fr * 68 + kb * 16 + fq * 4); }
            S5_CB();
            stageA(u1);
            S5_CB();
#pragma unroll
            for (int s = 0; s < 16; ++s) { const int tt = DIRC ? 15 - s : s;
                const float nr = __builtin_fmaf(abr, xr, __builtin_fmaf(nabi, xi, bu[s][0])); const float ni = __builtin_fmaf(abr, xi, __builtin_fmaf(abi, xr, bu[s][1])); xr = nr; xi = ni;
                XS[tt * 68 + lane] = pk2(xr, xi); }
            if (do_c) {
                f32x4 ya = (f32x4){0.f, 0.f, 0.f, 0.f};
#pragma unroll
                for (int kb = 0; kb < 4; ++kb) ya = MFMA16(Cb[kb], Ax[kb], ya);
                u32x2 w; w.x = pk2(ya[0], ya[1]); w.y = pk2(ya[2], ya[3]); *(u32x2*)(Y + (rowprev + fr) * D + g * 16 + fq * 4) = w; }
            S5_CB();
            rowprev = row0; u1 = u2; u2 = u3;
        };
        iter(0, false);
        for (int ci = 1; ci < 272; ++ci) iter(ci, true);
        {
            f32x4 ya = (f32x4){0.f, 0.f, 0.f, 0.f};
#pragma unroll
            for (int kb = 0; kb < 4; ++kb) { const bf16x8 Ax = *(const LAS bf16x8*)(XS + fr * 68 + kb * 16 + fq * 4); ya = MFMA16(Cb[kb], Ax, ya); }
            u32x2 w; w.x = pk2(ya[0], ya[1]); w.y = pk2(ya[2], ya[3]); *(u32x2*)(Y + (rowprev + fr) * D + g * 16 + fq * 4) = w;
        }
        LDS_WAIT();
        };
        if (dir) run_dir(std::true_type{}); else run_dir(std::false_type{});
#undef S5_CB
    }
}

DI float gelu_tanh(float x) { const float z = 0.7978845608028654f * (x + 0.044715f * x * x * x); const float e = __expf(2.f * z); const float th = 1.f - 2.f / (e + 1.f); return 0.5f * x * (1.f + th); }
DI void s5comb_phase(const bf16_t* H, const bf16_t* YF, const bf16_t* YB, const float* dsk, bf16_t* Gb, int nrows, int gt, int GT) {
    const size_t n8 = (size_t)nrows * (D / 8);
    for (size_t i = gt; i < n8; i += GT) {
        const int c = (int)(i & 127) * 8;
        float u[8], f1[8], f2[8], o[8];
        unpack8(*(const u32x4*)(H + i * 8), u); unpack8(*(const u32x4*)(YF + i * 8), f1); unpack8(*(const u32x4*)(YB + i * 8), f2);
        const f32x4 d0 = *(const f32x4*)(dsk + c), d1 = *(const f32x4*)(dsk + c + 4);
#pragma unroll
        for (int q = 0; q < 8; ++q) { const float dd = q < 4 ? d0[q] : d1[q - 4]; o[q] = gelu_tanh(f1[q] + f2[q] + dd * u[q]); }
        *(u32x4*)(Gb + i * 8) = pack8(o);
    }
}

#define XB_TMO      128
#define XB_XCNT(j)  (256  + 64 * (j))
#define XB_XSUB(j)  (1280 + 64 * (j))
#define XB_XGEN(j)  (2304 + 64 * (j))
#define XB_TOP      3328
#define XB_TOPGEN   3392
#define XCD_BAR_WORDS 3456
#define XB_SPIN_CAP (1u << 22)
DI unsigned xb_ld(unsigned* p)              { return __hip_atomic_load(p, __ATOMIC_RELAXED, __HIP_MEMORY_SCOPE_AGENT); }
DI unsigned xb_add(unsigned* p, unsigned v) { return __hip_atomic_fetch_add(p, v, __ATOMIC_RELAXED, __HIP_MEMORY_SCOPE_AGENT); }
DI unsigned xb_xcc_id() { return (unsigned)__builtin_amdgcn_s_getreg((3 << 11) | 20) & 0xFu; }
#define XB_SPIN(cond, bar) do { unsigned _sp = 0; while (cond) { __builtin_amdgcn_s_sleep(1); \
    if ((++_sp & 255u) == 0u) { if (xb_ld(&(bar)[XB_TMO])) break; if (_sp > XB_SPIN_CAP) { atomicAdd(&(bar)[XB_TMO], 1u); break; } } } } while (0)
struct XcdBarrier { unsigned* bar; unsigned x; volatile LAS unsigned* st; };
DI XcdBarrier xcd_barrier_post(unsigned* bar, volatile LAS unsigned* st) {
    XcdBarrier b; b.bar = bar; b.x = xb_xcc_id(); b.st = st;
    if (threadIdx.x == 0) (void)xb_add(&bar[XB_XCNT(b.x)], 1u);
    return b;
}
DI void xcd_barrier_complete(unsigned* bar, unsigned x, unsigned& nloc, unsigned& nx) {
    const unsigned G = gridDim.x * gridDim.y * gridDim.z;
    unsigned sum, cnt, mine, sp = 0u;
    for (;;) {
        sum = 0u; cnt = 0u; mine = 0u;
#pragma unroll
        for (unsigned j = 0; j < 16; ++j) { const unsigned c = xb_ld(&bar[XB_XCNT(j)]); sum += c; cnt += (c > 0u) ? 1u : 0u; mine = (j == x) ? c : mine; }
        if (sum == G) break;
        __builtin_amdgcn_s_sleep(1);
        if ((++sp & 255u) == 0u) { if (xb_ld(&bar[XB_TMO])) break; if (sp > XB_SPIN_CAP) { atomicAdd(&bar[XB_TMO], 1u); break; } }
    }
    nloc = mine > 0u ? mine : 1u; nx = cnt > 0u ? cnt : 1u;
}
DI void xcd_barrier(const XcdBarrier& b) {
    asm volatile("s_waitcnt vmcnt(0)" ::: "memory");
    __syncthreads();
    if (threadIdx.x == 0) {
        unsigned* bar = b.bar;
        __builtin_amdgcn_s_waitcnt(0);
        unsigned nloc = b.st[0], nx = b.st[1];
        if (nloc == 0u) { xcd_barrier_complete(bar, b.x, nloc, nx); b.st[0] = nloc; b.st[1] = nx; }
        const unsigned old = xb_add(&bar[XB_XSUB(b.x)], 1u);
        const unsigned gen = old / nloc;
        if (old + 1u == (gen + 1u) * nloc) {
            __builtin_amdgcn_fence(__ATOMIC_RELEASE, "agent");
            asm volatile("s_waitcnt vmcnt(0)" ::: "memory");
            const unsigned og = xb_add(&bar[XB_TOP], 1u);
            const unsigned tg = og / nx;
            if (og + 1u == (tg + 1u) * nx) xb_add(&bar[XB_TOPGEN], 1u);
            else XB_SPIN(xb_ld(&bar[XB_TOPGEN]) == tg, bar);
            __builtin_amdgcn_fence(__ATOMIC_ACQUIRE, "agent");
            xb_add(&bar[XB_XGEN(b.x)], 1u);
            asm volatile("s_waitcnt vmcnt(0)" ::: "memory");
        } else {
            XB_SPIN(xb_ld(&bar[XB_XGEN(b.x)]) == gen, bar);
            __builtin_amdgcn_fence(__ATOMIC_ACQUIRE, "agent");
            asm volatile("s_waitcnt vmcnt(0)" ::: "memory");
        }
    }
    __syncthreads();
}

#ifndef EN_MASK
#define EN_MASK 0xffff
#endif
#define EN(k) ((EN_MASK >> (k)) & 1)
#ifndef REP_MASK
#define REP_MASK 0
#endif
#define REPN(k) (1 + ((REP_MASK >> (k)) & 1))
enum { OP_NM1 = 0, OP_GZ, OP_GQP, OP_GKVP, OP_PREP, OP_RETATT, OP_RCOMB, OP_GOUT, OP_S5, OP_S5COMB, OP_GGLU, OP_NM2, OP_GM1, OP_GM2 };
DI int step_op(int s) {
    switch (s) {
        case 0: return OP_NM1; case 1: return OP_GZ; case 2: return OP_GQP; case 3: return OP_PREP; case 4: return OP_RETATT; case 5: return OP_RCOMB;
        case 6: return OP_GOUT; case 7: return OP_NM2; case 8: return OP_GM1; case 9: return OP_GM2;
        case 10: return OP_NM1; case 11: return OP_S5; case 12: return OP_S5COMB; case 13: return OP_GGLU; case 14: return OP_NM2; case 15: return OP_GM1; default: return OP_GM2;
    }
}

__global__ void __launch_bounds__(NTHREADS) fwd_kernel(KArgs a) {
    extern __shared__ __attribute__((aligned(16))) unsigned char lds_raw[];
    LAS unsigned char* lds = (LAS unsigned char*)lds_raw;
    cg::grid_group grid = cg::this_grid();
    volatile LAS unsigned* bst = (volatile LAS unsigned*)(lds + 133120);
    if (threadIdx.x == 0) { bst[0] = 0u; bst[1] = 0u; }
    __syncthreads();
    XcdBarrier xbar = xcd_barrier_post((unsigned*)(a.ws + OFF_BAR), bst);
    { const int tid = threadIdx.x, lane = tid & 63, wave = __builtin_amdgcn_readfirstlane(tid >> 6);
      if (EN(0)) phase0(a, lds, gridDim.x, blockIdx.x, tid, wave, lane); }

    if (a.ws == nullptr) grid.sync();
    xcd_barrier(xbar);

    for (int step = 0; step < 34; ++step) {
        int zz = 0; asm volatile("" : "+s"(zz));
        int tid = threadIdx.x; asm volatile("" : "+v"(tid));
        int G = gridDim.x, bid = blockIdx.x; asm volatile("" : "+s"(G), "+s"(bid));
        const int lane = tid & 63, wave = __builtin_amdgcn_readfirstlane(tid >> 6);
        const int gw = bid * 8 + wave, NGW = G * 8, gt = bid * NTHREADS + tid, GT = G * NTHREADS;
        unsigned char* ws = a.ws + zz; unsigned char* ar = ws + OFF_ARENA;
        float* XC = (float*)(ws + OFF_XC); float* outp = a.out + zz;
        const float* mod = (const float*)(ws + OFF_MOD);
        const int s18 = step % 17, l = (step / 17) * 2 + (s18 >= 10 ? 1 : 0), op = step_op(s18), e = l >> 1;
        const bool first = (l == 0) && (s18 < 7);
        const float* xl = first ? a.in[zz + 0] : outp; const float* xc = first ? a.in[zz + 2] : XC;
        const float* modl = mod + (size_t)l * 17 * 6144;
        const int Mrows = (l == 3) ? ML : M;
        int gkind = 0; pg8::Gemm gm{nullptr, nullptr, 0, 0, 0, 0}; bf16_t* gout = nullptr; int gldc = 0, gact = 0, gchunk = 0;
        switch (op) {
            case OP_NM1: for (int rep = 0; rep < REPN(1); ++rep) normmod_phase(xl, xc, a.in[zz + 6] + l * D, modl, 0, 1, (bf16_t*)(ar + ((l & 1) ? A_H0 : A_HB)), M, gw, NGW, lane,
                                   l > 0 ? (const float*)(ar + A_PART) : nullptr, modl - (size_t)17 * 6144 + (size_t)16 * 6144 + 5 * 1024, XC); break;
            case OP_NM2: for (int rep = 0; rep < REPN(1); ++rep) normmod_phase(xl, (l == 0) ? a.in[zz + 2] : xc, a.in[zz + 7] + l * D, modl, 3, 4, (bf16_t*)(ar + A_H0), Mrows, gw, NGW, lane,
                                   (l & 1) ? nullptr : (const float*)(ar + A_PART), modl + (size_t)16 * 6144 + 2 * 1024, XC); break;
            case OP_GZ: gkind = 1; gm = pg8::Gemm{(const bf16_t*)(ar + A_HB), (const bf16_t*)(ws + OFF_WINT) + (size_t)e * ZW * D, D, D, M, ZW, D, 1}; gout = (bf16_t*)(ar + A_Z); gldc = ZW; break;
            case OP_GQP: gkind = 1; gm = pg8::Gemm{(const bf16_t*)(ar + A_Z), (const bf16_t*)(ws + OFF_WUQT) + (size_t)e * 768 * 256, ZW, 256, M, 768, 256, 1}; gout = (bf16_t*)(ar + A_MIX); gldc = 768; break;
            case OP_GM1: gkind = 1; gm = pg8::Gemm{(const bf16_t*)(ar + A_H0), (const bf16_t*)(ws + OFF_W1T) + (size_t)l * FF * D, D, D, Mrows, FF, D, 1}; gout = (bf16_t*)(ar + A_HID); gldc = FF; gact = 1; break;
            case OP_GOUT: gkind = 2; gm = pg8::Gemm{(const bf16_t*)(ar + A_MIX), (const bf16_t*)(ws + OFF_WOUTT) + (size_t)e * D * D, D, D, ML, D, D, 1}; gchunk = 2; break;
            case OP_GM2: gkind = 2; gm = pg8::Gemm{(const bf16_t*)(ar + A_HID), (const bf16_t*)(ws + OFF_W2T) + (size_t)l * D * FF, FF, FF, ML, D, FF, 1}; gchunk = 5; break;
            case OP_GGLU: gkind = 3; gm = pg8::Gemm{(const bf16_t*)(ar + A_G), (const bf16_t*)(ws + OFF_WGLUT) + (size_t)(l >> 1) * 2048 * D, D, D, Mrows, 2048, D, 1}; gchunk = 2; break;
            case OP_PREP: for (int rep = 0; rep < REPN(2); ++rep) prep_phase(a, zz, e, (const bf16_t*)(ar + A_Z), (const bf16_t*)(ar + A_MIX), (const bf16_t*)(ar + A_HB), (bf16_t*)(ar + A_Q), (bf16_t*)(ar + A_K), (bf16_t*)(ar + A_VT), lds, G, bid, tid, wave, lane); break;
            case OP_RETATT:
                for (int rep = 0; rep < REPN(3); ++rep) ret_phase(a, zz, e, (const bf16_t*)(ar + A_Z), (bf16_t*)(ar + A_HB), (bf16_t*)(ar + A_HB) + (size_t)M * 512, lds, G, bid, tid, wave, lane);
                for (int rep = 0; rep < REPN(4); ++rep) attn_phase((const bf16_t*)(ar + A_Q), (const bf16_t*)(ar + A_K), (const bf16_t*)(ar + A_VT), (bf16_t*)(ar + A_MIX), lds, G, bid, tid, wave, lane);
                break;
            case OP_RCOMB: for (int rep = 0; rep < REPN(5); ++rep) retcomb_phase((const bf16_t*)(ar + A_Z), (const bf16_t*)(ar + A_HB), (const bf16_t*)(ar + A_HB) + (size_t)M * 512, (bf16_t*)(ar + A_MIX), gw, NGW, lane); break;
            case OP_S5: for (int rep = 0; rep < REPN(6); ++rep) s5_phase(a, zz, l >> 1, (const bf16_t*)(ar + A_H0), (bf16_t*)(ar + A_YF), (bf16_t*)(ar + A_YB), lds, G, bid, wave, lane); break;
            case OP_S5COMB: for (int rep = 0; rep < REPN(7); ++rep) s5comb_phase((const bf16_t*)(ar + A_H0), (const bf16_t*)(ar + A_YF), (const bf16_t*)(ar + A_YB), a.in[zz + 34] + (l >> 1) * D, (bf16_t*)(ar + A_G), Mrows, gt, GT); break;
            default: break;
        }
        const int ngemm = (op == OP_GQP || op == OP_GOUT || (op == OP_GM2 && l < 3)) ? 2 : 1;
        int tidg = threadIdx.x; asm volatile("" : "+v"(tidg));
        if (gkind) for (int gi = 0; gi < ngemm; ++gi) {
            if (gi == 1) {
                if (op == OP_GQP) { gm = pg8::Gemm{(const bf16_t*)(ar + A_Z) + 256, (const bf16_t*)(ws + OFF_WUKVT) + (size_t)e * 1024 * 256, ZW, 256, M, 1024, 256, 1}; gout = (bf16_t*)(ar + A_HB); gldc = 1024; }
                else if (op == OP_GOUT) { gkind = 4; gm = pg8::Gemm{(const bf16_t*)(ar + A_MIX) + (size_t)ML * D, (const bf16_t*)(ws + OFF_WOUTT) + (size_t)e * D * D, D, D, MC, D, D / 4, 4}; }
                else { gkind = 4; gm = pg8::Gemm{(const bf16_t*)(ar + A_HID) + (size_t)ML * FF, (const bf16_t*)(ws + OFF_W2T) + (size_t)l * D * FF, FF, FF, MC, D, FF / 4, 4}; }
            }
            pg8::StaticOrder S; S.init(gm.M, gm.N, G, bid, gm.ksplit);
            if (gkind == 1) { pg8::EpiStore E{gout, gldc, gact}; pg8::gemm_phase(lds, tidg, gm, S, E); }
            else if (gkind == 2) { pg8::EpiResid E{xl, xc, outp, XC, modl + gchunk * 1024}; pg8::gemm_phase(lds, tidg, gm, S, E); }
            else if (gkind == 3) { pg8::EpiGlu E{xl, xc, outp, XC, modl + gchunk * 1024}; pg8::gemm_phase(lds, tidg, gm, S, E); }
            else { pg8::EpiPart E{(float*)(ar + A_PART), MC}; pg8::gemm_phase(lds, tidg, gm, S, E); }
        }
        xcd_barrier(xbar);
        if (REPN(15) > 1) xcd_barrier(xbar);
    }
}

extern "C" void kernel_launch(void* const* d_in, const int* in_sizes, int n_in, void* d_out, int out_size, void* d_ws, size_t ws_size, hipStream_t stream) {
    static int grid_blocks = 0;
    if (!grid_blocks) {
        if (n_in != 36 || out_size != ML * D || ws_size < WS_NEED) { fprintf(stderr, "kernel_launch: unexpected problem (n_in %d, out %d, ws %zu < %zu)\n", n_in, out_size, ws_size, (size_t)WS_NEED); grid_blocks = -1; return; }
        int dev = 0, cus = 0, per_cu = 0;
        (void)hipGetDevice(&dev);
        (void)hipDeviceGetAttribute(&cus, hipDeviceAttributeMultiprocessorCount, dev);
        (void)hipFuncSetAttribute((const void*)fwd_kernel, hipFuncAttributeMaxDynamicSharedMemorySize, LDS_BYTES);
        (void)hipOccupancyMaxActiveBlocksPerMultiprocessor(&per_cu, (const void*)fwd_kernel, NTHREADS, LDS_BYTES);
        if (per_cu < 1) per_cu = 1;
        grid_blocks = cus * per_cu;
    }
    if (grid_blocks < 0) return;
    if (hipMemsetAsync((unsigned char*)d_ws + OFF_BAR, 0, BAR_BYTES, stream) != hipSuccess) { fprintf(stderr, "kernel_launch: memset of barrier words failed\n"); return; }
    KArgs a{};
    for (int i = 0; i < 36; ++i) a.in[i] = (const float*)d_in[i];
    a.out = (float*)d_out; a.ws = (unsigned char*)d_ws;
    void* args[] = {&a};
    hipError_t err = hipLaunchCooperativeKernel((void*)fwd_kernel, dim3(grid_blocks), dim3(NTHREADS), args, LDS_BYTES, stream);
    if (err != hipSuccess) fprintf(stderr, "cooperative launch failed: %s (grid %d)\n", hipGetErrorString(err), grid_blocks);
}
```

```cpp
#include <hip/hip_runtime.h>
#include <hip/hip_cooperative_groups.h>
#include <cstdio>
#include <cstdint>
#include <type_traits>
namespace cg = cooperative_groups;

#define LAS __attribute__((address_space(3)))
#define DI __device__ __forceinline__
typedef unsigned short bf16_t;
typedef short bf16x8 __attribute__((ext_vector_type(8)));
typedef short s16x4 __attribute__((ext_vector_type(4)));
typedef float f32x4 __attribute__((ext_vector_type(4)));
typedef float f32x2 __attribute__((ext_vector_type(2)));
typedef float f32x16 __attribute__((ext_vector_type(16)));
typedef unsigned u32x4 __attribute__((ext_vector_type(4)));
typedef unsigned u32x2 __attribute__((ext_vector_type(2)));
typedef __bf16 bf16x2_t __attribute__((ext_vector_type(2)));

constexpr int NB = 16, T = 4096, TC = 256, D = 1024, FF = 4096;
constexpr int ML = NB * T, MC = NB * TC, M = ML + MC, TK = T + TC;
constexpr int ZW = 2560;
constexpr float EPS = 1e-6f;
constexpr float LOG2E = 1.4426950408889634f;
constexpr float QSCALE = 0.10206207261596575f * LOG2E;
constexpr int NTHREADS = 512;
constexpr int LDS_BYTES = 135168;

constexpr size_t OFF_W1T = 0;
constexpr size_t OFF_W2T = OFF_W1T + (size_t)4 * FF * D * 2;
constexpr size_t OFF_WINT = OFF_W2T + (size_t)4 * FF * D * 2;
constexpr size_t OFF_WUQT = OFF_WINT + (size_t)2 * ZW * D * 2;
constexpr size_t OFF_WUKVT = OFF_WUQT + (size_t)2 * 768 * 256 * 2;
constexpr size_t OFF_WOUTT = OFF_WUKVT + (size_t)2 * 1024 * 256 * 2;
constexpr size_t OFF_WGLUT = OFF_WOUTT + (size_t)2 * D * D * 2;
constexpr size_t OFF_MOD = OFF_WGLUT + (size_t)2 * 2048 * D * 2;
constexpr size_t OFF_XC = OFF_MOD + (size_t)4 * 17 * 6144 * 4;
constexpr size_t OFF_TABR = OFF_XC + (size_t)MC * D * 4;
constexpr size_t OFF_TABA = OFF_TABR + (size_t)T * 32 * 8;
constexpr size_t OFF_BAR = OFF_TABA + (size_t)T * 16 * 8;
constexpr size_t BAR_BYTES = 16384;
constexpr size_t OFF_ARENA = OFF_BAR + BAR_BYTES;
constexpr size_t A_Z = 0;
constexpr size_t A_HB = A_Z + (size_t)M * ZW * 2;
constexpr size_t A_MIX = A_HB + (size_t)M * D * 2;
constexpr size_t A_Q = A_MIX + (size_t)M * 768 * 2 + (size_t)M * 384 * 2;
constexpr size_t A_K = A_Q + (size_t)M * 768 * 2;
constexpr size_t A_VT = A_K + (size_t)M * 768 * 2;
constexpr size_t A_END_EVEN = A_VT + (size_t)M * 512 * 2;
constexpr size_t A_H0 = 0;
constexpr size_t A_HID = A_H0 + (size_t)M * D * 2;
constexpr size_t A_PART = A_HID + (size_t)M * FF * 2;
constexpr size_t A_END_MLP = A_PART + (size_t)4 * MC * D * 4;
constexpr size_t A_YF = A_H0 + (size_t)M * D * 2;
constexpr size_t A_YB = A_YF + (size_t)M * D * 2;
constexpr size_t A_G = A_YB + (size_t)M * D * 2;
constexpr size_t WS_NEED = OFF_ARENA + (A_END_EVEN > A_END_MLP ? A_END_EVEN : A_END_MLP);
static_assert((size_t)M * 768 * 2 + (size_t)M * 384 * 2 >= (size_t)M * D * 2, "MIX fits its region");

struct KArgs { const float* in[36]; float* out; unsigned char* ws; };

DI unsigned pk2(float lo, float hi) { f32x2 v = {lo, hi}; bf16x2_t b = __builtin_convertvector(v, bf16x2_t); return __builtin_bit_cast(unsigned, b); }
DI float bflo(unsigned u) { return __uint_as_float(u << 16); }
DI float bfhi(unsigned u) { return __uint_as_float(u & 0xffff0000u); }
DI float bf1(bf16_t h) { return __uint_as_float(((unsigned)h) << 16); }
DI bf16_t f2bf(float f) { return (bf16_t)(pk2(f, 0.f) & 0xffffu); }
DI void unpack8(u32x4 v, float* f) { f[0] = bflo(v.x); f[1] = bfhi(v.x); f[2] = bflo(v.y); f[3] = bfhi(v.y); f[4] = bflo(v.z); f[5] = bfhi(v.z); f[6] = bflo(v.w); f[7] = bfhi(v.w); }
DI u32x4 pack8(const float* f) { u32x4 o; o.x = pk2(f[0], f[1]); o.y = pk2(f[2], f[3]); o.z = pk2(f[4], f[5]); o.w = pk2(f[6], f[7]); return o; }
DI float wave_sum(float v) {
#pragma unroll
    for (int o = 1; o < 64; o <<= 1) v += __shfl_xor(v, o);
    return v;
}
#define LDS_WAIT() asm volatile("s_waitcnt lgkmcnt(0)" ::: "memory")
DI float sin_rev(float r) { return __builtin_amdgcn_sinf(r); }
DI float cos_rev(float r) { return __builtin_amdgcn_cosf(r); }
#define MFMA16(a, b, c) __builtin_amdgcn_mfma_f32_16x16x32_bf16((a), (b), (c), 0, 0, 0)
#define MFMA32(a, b, c) __builtin_amdgcn_mfma_f32_32x32x16_bf16((a), (b), (c), 0, 0, 0)

namespace pg8 {
constexpr int BM = 256, BK = 64, HALF = 128, HTB = HALF * BK * 2, STAGE_BYTES = 8 * HTB, NXCD = 8, WGM = 8;
DI int lds_byte(int r, int c) { const int st = (r >> 4) * 2 + (c >> 5), rr = r & 15, cc = c & 31, ob = rr * 64 + cc * 2; return st * 1024 + (ob ^ (((ob >> 9) & 1) << 5)); }
DI void stage_rc(int b, int& R, int& C) { const int st = b / 1024, sb = b % 1024, swz = sb ^ (((sb >> 9) & 1) << 5); R = (st >> 1) * 16 + swz / 64; C = (st & 1) * 32 + (swz % 64) / 2; }
DI int perm32(int rho) { const int n = rho >> 4, i = rho & 15; return 8 * (i >> 2) + 4 * n + (i & 3); }
struct Unit { int pm, pn, ks; };
struct Gemm { const bf16_t* A; const bf16_t* Bt; int lda, ldb, M, N, K, ksplit; };
struct StaticOrder {
    int nM, nN, nNr, nwg, G, c;
    DI void init(int M_, int N_, int G_, int c_, int ksplit) { nM = M_ / BM; nNr = N_ / BM; nN = nNr * ksplit; nwg = nM * nN; G = G_; c = c_; }
    DI bool next(int i, Unit& u) const {
        const long L = (long)i * G + c; if (L >= nwg) return false;
        int wgid = (int)L; { const int q = nwg / NXCD, r = nwg % NXCD, xcd = wgid % NXCD, off = wgid / NXCD; wgid = (xcd < r ? xcd * (q + 1) : r * (q + 1) + (xcd - r) * q) + off; }
        const int nig = WGM * nN, gid = wgid / nig, fm = gid * WGM, gsz = (nM - fm) < WGM ? (nM - fm) : WGM;
        u.pm = fm + ((wgid % nig) % gsz); const int pv_ = (wgid % nig) / gsz; u.ks = pv_ / nNr; u.pn = pv_ - u.ks * nNr; return true;
    }
};
template <class Epi>
DI void gemm_phase(LAS unsigned char* lds, const int tid, const Gemm g, const StaticOrder& S, const Epi& E) {
    const int wid = __builtin_amdgcn_readfirstlane(tid >> 6), lane = tid & 63, wr = wid >> 2, wc = wid & 3, fr = lane & 15, fq = lane >> 4;
    const int K = g.K, nt = K / BK, lda = g.lda, ldb = g.ldb;
    unsigned voffA[2], voffB[2];
#pragma unroll
    for (int i = 0; i < 2; ++i) { int R, C; stage_rc(tid * 16 + i * 8192, R, C); const int Rb = (R & ~31) + perm32(R & 31);
        voffA[i] = (unsigned)(R * lda + C) * 2u; voffB[i] = (unsigned)(Rb * ldb + C) * 2u; }
    const size_t kstep = (size_t)(BK * 2);
    const size_t hstA = (size_t)HALF * lda * 2, hstB = (size_t)HALF * ldb * 2, ksb = (size_t)K * 2;
    const size_t tstA = 2 * hstA, tstB = 2 * hstB;
    const unsigned ldsw = (unsigned)wid * 1024u;
    const int aoff = lds_byte(wr * 64 + fr, fq * 8), boff = lds_byte(wc * 32 + fr, fq * 8);
#define PG8_SA(b, h) (((b) * 2 + (h)) * HTB)
#define PG8_SB(b, h) ((4 + (b) * 2 + (h)) * HTB)
#define PG8_STAGE(bufoff, gbase, voff) do { _Pragma("unroll") for (int _i = 0; _i < 2; ++_i) \
        __builtin_amdgcn_global_load_lds((const unsigned*)((const char*)(gbase) + (voff)[_i]), (LAS unsigned*)(lds + (bufoff) + ldsw + _i * 8192), 16, 0, 0); } while (0)
#define PG8_LDA(dst, b, h) do { _Pragma("unroll") for (int m = 0; m < 4; ++m) _Pragma("unroll") for (int k = 0; k < 2; ++k) dst[m][k] = *(const LAS bf16x8*)(lds + PG8_SA(b, h) + aoff + m * 2048 + k * 1024); } while (0)
#define PG8_LDB(dst, b, h) do { _Pragma("unroll") for (int n = 0; n < 2; ++n) _Pragma("unroll") for (int k = 0; k < 2; ++k) dst[n][k] = *(const LAS bf16x8*)(lds + PG8_SB(b, h) + boff + n * 2048 + k * 1024); } while (0)
#define PG8_MMA(ai, bj, At, Bt) do { __builtin_amdgcn_s_setprio(1); _Pragma("unroll") for (int m = 0; m < 4; ++m) _Pragma("unroll") for (int n = 0; n < 2; ++n) _Pragma("unroll") for (int k = 0; k < 2; ++k) \
        acc[ai][bj][m][n] = __builtin_amdgcn_mfma_f32_16x16x32_bf16(Bt[n][k], At[m][k], acc[ai][bj][m][n], 0, 0, 0); __builtin_amdgcn_s_setprio(0); } while (0)
#define PG8_WAIT_V(n) asm volatile("s_waitcnt vmcnt(" #n ")" ::: "memory")
#define PG8_WAIT_L(n) asm volatile("s_waitcnt lgkmcnt(" #n ")" ::: "memory")
#define PG8_BAR __builtin_amdgcn_s_barrier()
#define PG8_SCHED __builtin_amdgcn_sched_barrier(0)
    Unit cur, nxt; int ui = 0;
    if (!S.next(0, cur)) return;
    f32x4 acc[2][2][4][2];
#pragma unroll
    for (int a = 0; a < 2; ++a)
#pragma unroll
        for (int b = 0; b < 2; ++b)
#pragma unroll
            for (int m = 0; m < 4; ++m)
#pragma unroll
                for (int n = 0; n < 2; ++n) acc[a][b][m][n] = (f32x4){0.f, 0.f, 0.f, 0.f};
    bf16x8 At[4][2], B0[2][2], B1[2][2];
    const char* cA = (const char*)g.A + (size_t)cur.pm * tstA + (size_t)cur.ks * ksb; const char* cB = (const char*)g.Bt + (size_t)cur.pn * tstB + (size_t)cur.ks * ksb;
    PG8_STAGE(PG8_SB(0, 0), cB, voffB); PG8_STAGE(PG8_SB(0, 1), cB + hstB, voffB); PG8_STAGE(PG8_SA(0, 0), cA, voffA); PG8_STAGE(PG8_SA(0, 1), cA + hstA, voffA);
    if (wr == 1) PG8_BAR;
    PG8_WAIT_V(2); PG8_BAR;
    PG8_STAGE(PG8_SB(1, 0), cB + kstep, voffB); PG8_STAGE(PG8_SA(1, 0), cA + kstep, voffA); PG8_STAGE(PG8_SB(1, 1), cB + hstB + kstep, voffB);
    PG8_WAIT_V(6); PG8_BAR;
    for (;;) {
        const bool has_next = S.next(ui + 1, nxt);
        const char* nA = has_next ? (const char*)g.A + (size_t)nxt.pm * tstA + (size_t)nxt.ks * ksb : cA; const char* nB = has_next ? (const char*)g.Bt + (size_t)nxt.pn * tstB + (size_t)nxt.ks * ksb : cB;
        for (int t = 0; t < nt; t += 2) {
            const bool last = (t == nt - 2);
            const char* a1 = cA + (size_t)(t + 1) * kstep;
            const char* a2 = last ? nA : cA + (size_t)(t + 2) * kstep; const char* b2 = last ? nB : cB + (size_t)(t + 2) * kstep;
            const char* a3 = a2 + kstep; const char* b3 = b2 + kstep;
            PG8_LDB(B0, 0, 0); PG8_LDB(B1, 0, 1); PG8_SCHED; PG8_LDA(At, 0, 0); PG8_STAGE(PG8_SA(1, 1), a1 + hstA, voffA);
            PG8_WAIT_V(8); PG8_WAIT_L(0); PG8_BAR; PG8_MMA(0, 0, At, B0); PG8_MMA(0, 1, At, B1); PG8_BAR; PG8_SCHED;
            PG8_LDA(At, 0, 1); PG8_STAGE(PG8_SB(0, 0), b2, voffB); PG8_STAGE(PG8_SB(0, 1), b2 + hstB, voffB); PG8_STAGE(PG8_SA(0, 0), a2, voffA);
            PG8_WAIT_V(8); PG8_WAIT_L(0); PG8_BAR; PG8_MMA(1, 0, At, B0); PG8_MMA(1, 1, At, B1); PG8_BAR; PG8_SCHED;
            PG8_LDB(B0, 1, 0); PG8_LDB(B1, 1, 1); PG8_SCHED; PG8_LDA(At, 1, 0); PG8_STAGE(PG8_SA(0, 1), a2 + hstA, voffA);
            PG8_WAIT_V(8); PG8_WAIT_L(0); PG8_BAR; PG8_MMA(0, 0, At, B0); PG8_MMA(0, 1, At, B1); PG8_BAR; PG8_SCHED;
            PG8_LDA(At, 1, 1); PG8_STAGE(PG8_SB(1, 0), b3, voffB); PG8_STAGE(PG8_SB(1, 1), b3 + hstB, voffB); PG8_STAGE(PG8_SA(1, 0), a3, voffA);
            PG8_WAIT_V(8); PG8_WAIT_L(0); PG8_BAR; PG8_MMA(1, 0, At, B0); PG8_MMA(1, 1, At, B1); PG8_BAR; PG8_SCHED;
        }
        if (wr == 0) PG8_BAR;
        E(acc, cur, wr, wc, fr, fq);
        if (!has_next) break;
#pragma unroll
        for (int a = 0; a < 2; ++a)
#pragma unroll
            for (int b = 0; b < 2; ++b)
#pragma unroll
                for (int m = 0; m < 4; ++m)
#pragma unroll
                    for (int n = 0; n < 2; ++n) acc[a][b][m][n] = (f32x4){0.f, 0.f, 0.f, 0.f};
        cur = nxt; cA = nA; cB = nB; ++ui;
        if (wr == 1) PG8_BAR;
    }
    PG8_WAIT_V(0);
    PG8_BAR;
#undef PG8_SA
#undef PG8_SB
#undef PG8_STAGE
#undef PG8_LDA
#undef PG8_LDB
#undef PG8_MMA
#undef PG8_WAIT_V
#undef PG8_WAIT_L
#undef PG8_BAR
#undef PG8_SCHED
}

struct EpiStore {
    bf16_t* O; int ldc; int act;
    DI void operator()(const f32x4 (&acc)[2][2][4][2], const Unit& u, int wr, int wc, int fr, int fq) const {
        const int row0 = u.pm * BM + wr * 64 + fr, col0 = u.pn * BM + wc * 32 + 8 * fq;
#pragma unroll
        for (int ai = 0; ai < 2; ++ai)
#pragma unroll
            for (int m = 0; m < 4; ++m) { bf16_t* rowp = O + (size_t)(row0 + ai * HALF + m * 16) * ldc + col0;
#pragma unroll
                for (int bj = 0; bj < 2; ++bj) { f32x4 v0 = acc[ai][bj][m][0], v1 = acc[ai][bj][m][1];
                    if (act) {
#pragma unroll
                        for (int q = 0; q < 4; ++q) { float a = fmaxf(v0[q], 0.f), b = fmaxf(v1[q], 0.f); v0[q] = a * a; v1[q] = b * b; } }
                    u32x4 w; w.x = pk2(v0[0], v0[1]); w.y = pk2(v0[2], v0[3]); w.z = pk2(v1[0], v1[1]); w.w = pk2(v1[2], v1[3]);
                    *(u32x4*)(rowp + bj * HALF) = w; } }
    }
};
struct EpiPart {
    float* P; int rows;
    DI void operator()(const f32x4 (&acc)[2][2][4][2], const Unit& u, int wr, int wc, int fr, int fq) const {
        const int row0 = u.pm * BM + wr * 64 + fr, col0 = u.pn * BM + wc * 32 + 8 * fq;
        float* base = P + (size_t)u.ks * rows * D;
#pragma unroll
        for (int ai = 0; ai < 2; ++ai)
#pragma unroll
            for (int m = 0; m < 4; ++m) { float* rowp = base + (size_t)(row0 + ai * HALF + m * 16) * D + col0;
#pragma unroll
                for (int bj = 0; bj < 2; ++bj) { *(f32x4*)(rowp + bj * HALF) = acc[ai][bj][m][0]; *(f32x4*)(rowp + bj * HALF + 4) = acc[ai][bj][m][1]; } }
    }
};
struct EpiResid {
    const float* src_l; const float* src_c; float* dst_l; float* dst_c; const float* gate;
    DI void operator()(const f32x4 (&acc)[2][2][4][2], const Unit& u, int wr, int wc, int fr, int fq) const {
        const int trow = u.pm * BM; const bool lat = trow < ML;
        const float* src = lat ? src_l : src_c; float* dst = lat ? dst_l : dst_c;
        const int rbase = (lat ? trow : trow - ML) + wr * 64 + fr; const int grow = lat ? (trow >> 12) : 16;
        const float* gp = gate + (size_t)grow * 6144;
        const int col0 = u.pn * BM + wc * 32 + 8 * fq;
#pragma unroll
        for (int bj = 0; bj < 2; ++bj) {
            const int col = col0 + bj * HALF;
            const f32x4 g0 = *(const f32x4*)(gp + col), g1 = *(const f32x4*)(gp + col + 4);
#pragma unroll
            for (int ai = 0; ai < 2; ++ai)
#pragma unroll
                for (int m = 0; m < 4; ++m) { const size_t off = (size_t)(rbase + ai * HALF + m * 16) * D + col;
                    const f32x4 x0 = *(const f32x4*)(src + off), x1 = *(const f32x4*)(src + off + 4);
                    *(f32x4*)(dst + off) = x0 + g0 * acc[ai][bj][m][0]; *(f32x4*)(dst + off + 4) = x1 + g1 * acc[ai][bj][m][1]; }
        }
    }
};
struct EpiGlu {
    const float* src_l; const float* src_c; float* dst_l; float* dst_c; const float* gate;
    DI void operator()(const f32x4 (&acc)[2][2][4][2], const Unit& u, int wr, int wc, int fr, int fq) const {
        const int trow = u.pm * BM; const bool lat = trow < ML;
        const float* src = lat ? src_l : src_c; float* dst = lat ? dst_l : dst_c;
        const int rbase = (lat ? trow : trow - ML) + wr * 64 + fr; const int grow = lat ? (trow >> 12) : 16;
        const float* gp = gate + (size_t)grow * 6144;
        const int col0 = u.pn * BM + wc * 32 + 8 * fq;
#pragma unroll
        for (int bj = 0; bj < 2; ++bj) {
            const int col = (col0 + bj * HALF) >> 1;
            const f32x4 g0 = *(const f32x4*)(gp + col);
#pragma unroll
            for (int ai = 0; ai < 2; ++ai)
#pragma unroll
                for (int m = 0; m < 4; ++m) { const size_t off = (size_t)(rbase + ai * HALF + m * 16) * D + col;
                    const f32x4 x0 = *(const f32x4*)(src + off); const f32x4 za = acc[ai][bj][m][0], zb = acc[ai][bj][m][1]; f32x4 o;
#pragma unroll
                    for (int q = 0; q < 4; ++q) o[q] = za[q] / (1.f + __expf(-zb[q]));
                    *(f32x4*)(dst + off) = x0 + g0 * o; }
        }
    }
};
}

DI int map_col(int mode, int n) {
    if (mode == 0) return n;
    if (mode == 1) return n < 416 ? n : (n < 512 ? -1 : n - 96);
    const int q = n >> 3, i = n & 7; return i < 4 ? 4 * q + i : 1024 + 4 * q + (i - 4);
}
DI void xpose_item(const float* W, int ldw, int Ks, bf16_t* WT, int Kd, int Nd, int mode, const float* scale, LAS float* scr, int item, int lane) {
    const int nblk = Nd / 32, kb = item / nblk, nb = item % nblk, k0 = 64 * kb, n0 = 32 * nb;
    const int sc = map_col(mode, n0 + (lane & 31));
    float wv[32];
    const bool okc = sc >= 0; const int scc = okc ? sc : 0;
#pragma unroll
    for (int i = 0; i < 32; ++i) { const int kk = 2 * i + (lane >> 5), k = k0 + kk; const int kc = k < Ks ? k : Ks - 1;
        float v = W[(size_t)kc * ldw + scc]; if (scale) v *= scale[kc];
        wv[i] = (okc && k < Ks) ? v : 0.f; }
#pragma unroll
    for (int i = 0; i < 32; ++i) { const int kk = 2 * i + (lane >> 5); scr[kk * 33 + (lane & 31)] = wv[i]; }
    LDS_WAIT();
    const int c = lane & 7;
#pragma unroll
    for (int j = 0; j < 4; ++j) { const int n = (lane >> 3) + 8 * j; const LAS float* s = scr + (8 * c) * 33 + n;
        u32x4 o; o.x = pk2(s[0 * 33], s[1 * 33]); o.y = pk2(s[2 * 33], s[3 * 33]); o.z = pk2(s[4 * 33], s[5 * 33]); o.w = pk2(s[6 * 33], s[7 * 33]);
        *(u32x4*)(WT + (size_t)(n0 + n) * Kd + k0 + 8 * c) = o; }
    LDS_WAIT();
}

DI void phase0(const KArgs& a, LAS unsigned char* lds, int G, int bid, int tid, int wave, int lane) {
    unsigned char* ws = a.ws;
    {
        LAS float* scr = (LAS float*)(lds + wave * 8448);
        const int gw = bid * 8 + wave, NGW = G * 8;
        constexpr int I_W1 = 2048, I_W2 = 2048, I_WIN = 1280, I_WUQ = 96, I_WUKV = 128, I_WOUT = 512, I_WGLU = 1024;
        constexpr int TOT = 4 * I_W1 + 4 * I_W2 + 2 * (I_WIN + I_WUQ + I_WUKV + I_WOUT + I_WGLU);
        for (int it = gw; it < TOT; it += NGW) {
            int r = it;
            if (r < 4 * I_W1) { const int l = r / I_W1; xpose_item(a.in[8] + (size_t)l * D * FF, FF, D, (bf16_t*)(ws + OFF_W1T) + (size_t)l * FF * D, D, FF, 0, nullptr, scr, r % I_W1, lane); continue; } r -= 4 * I_W1;
            if (r < 4 * I_W2) { const int l = r / I_W2; xpose_item(a.in[9] + (size_t)l * FF * D, D, FF, (bf16_t*)(ws + OFF_W2T) + (size_t)l * D * FF, FF, D, 0, nullptr, scr, r % I_W2, lane); continue; } r -= 4 * I_W2;
            if (r < 2 * I_WIN) { const int e = r / I_WIN; xpose_item(a.in[10] + (size_t)e * D * 2464, 2464, D, (bf16_t*)(ws + OFF_WINT) + (size_t)e * ZW * D, D, ZW, 1, nullptr, scr, r % I_WIN, lane); continue; } r -= 2 * I_WIN;
            if (r < 2 * I_WUQ) { const int e = r / I_WUQ; xpose_item(a.in[12] + (size_t)e * 256 * 768, 768, 256, (bf16_t*)(ws + OFF_WUQT) + (size_t)e * 768 * 256, 256, 768, 0, a.in[11] + e * 256, scr, r % I_WUQ, lane); continue; } r -= 2 * I_WUQ;
            if (r < 2 * I_WUKV) { const int e = r / I_WUKV; xpose_item(a.in[14] + (size_t)e * 128 * 1024, 1024, 128, (bf16_t*)(ws + OFF_WUKVT) + (size_t)e * 1024 * 256, 256, 1024, 0, a.in[13] + e * 128, scr, r % I_WUKV, lane); continue; } r -= 2 * I_WUKV;
            if (r < 2 * I_WOUT) { const int e = r / I_WOUT; xpose_item(a.in[19] + (size_t)e * D * D, D, D, (bf16_t*)(ws + OFF_WOUTT) + (size_t)e * D * D, D, D, 0, nullptr, scr, r % I_WOUT, lane); continue; } r -= 2 * I_WOUT;
            { const int o = r / I_WGLU; xpose_item(a.in[35] + (size_t)o * D * 2048, 2048, D, (bf16_t*)(ws + OFF_WGLUT) + (size_t)o * 2048 * D, D, 2048, 2, nullptr, scr, r % I_WGLU, lane); }
        }
    }
    {
        const int gt = bid * NTHREADS + tid, GT = G * NTHREADS;
        f32x2* tabr = (f32x2*)(ws + OFF_TABR); f32x2* taba = (f32x2*)(ws + OFF_TABA);
        for (int i = gt; i < T * 32; i += GT) { const int n = i >> 5, f = i & 31;
            const float th = exp2f(-(float)f * (13.287712379549449f / 32.f));
            double rev = (double)n * (double)th * 0.15915494309189535; rev -= floor(rev);
            tabr[i] = (f32x2){cos_rev((float)rev), sin_rev((float)rev)}; }
        for (int i = gt; i < T * 16; i += GT) { const int n = i >> 4, f = i & 15;
            const float th = exp2f(-(float)(f & 7) * (13.287712379549449f / 8.f));
            const int pos = (f < 8) ? (n >> 6) : (n & 63);
            double rev = (double)pos * (double)th * 0.15915494309189535; rev -= floor(rev);
            taba[i] = (f32x2){cos_rev((float)rev), sin_rev((float)rev)}; }
    }
    __syncthreads();
    {
        LAS float* sc = (LAS float*)lds;
        LAS float* part = (LAS float*)(lds + 69632);
        float* mod = (float*)(ws + OFF_MOD);
        if (bid < 384) {
            for (int i = tid; i < 17 * 1024; i += NTHREADS) { const int r = i >> 10, k = i & 1023; const float v = r < 16 ? a.in[1][r * 1024 + k] : a.in[3][k]; sc[i] = v / (1.f + __expf(-v)); }
            __syncthreads();
            for (int item = bid; item < 384; item += G) {
                const int l = item / 96, j0 = (item % 96) * 64;
                const float* W = a.in[4] + (size_t)l * D * 6144 + j0 + lane;
                float acc[17];
#pragma unroll
                for (int r = 0; r < 17; ++r) acc[r] = 0.f;
#pragma unroll 4
                for (int k4 = wave * 128; k4 < wave * 128 + 128; k4 += 4) {
                    const float w0 = W[(size_t)k4 * 6144], w1 = W[(size_t)(k4 + 1) * 6144], w2 = W[(size_t)(k4 + 2) * 6144], w3 = W[(size_t)(k4 + 3) * 6144];
#pragma unroll
                    for (int r = 0; r < 17; ++r) { const f32x4 s = *(const LAS f32x4*)(sc + r * 1024 + k4); acc[r] += s[0] * w0 + s[1] * w1 + s[2] * w2 + s[3] * w3; }
                }
#pragma unroll
                for (int r = 0; r < 17; ++r) part[(wave * 17 + r) * 64 + lane] = acc[r];
                __syncthreads();
                for (int i = tid; i < 17 * 64; i += NTHREADS) { const int r = i >> 6, j = i & 63; float s = a.in[5][l * 6144 + j0 + j];
#pragma unroll
                    for (int w = 0; w < 8; ++w) s += part[(w * 17 + r) * 64 + j];
                    mod[(size_t)(l * 17 + r) * 6144 + j0 + j] = s; }
                __syncthreads();
            }
        }
    }
}

DI void normmod_phase(const float* xl, const float* xc, const float* g, const float* modl  , int cshift, int cscale, bf16_t* H, int nrows, int gw, int NGW, int lane,
                      const float* part  , const float* pgate  , float* xc_out) {
    auto ld = [&](const int row, f32x4 (&v)[4]) __attribute__((always_inline)) -> float {
        const bool lat = row < ML;
        const float* xr = lat ? xl + (size_t)row * D : xc + (size_t)(row - ML) * D;
        float ss = 0.f;
#pragma unroll
        for (int j = 0; j < 4; ++j) { v[j] = *(const f32x4*)(xr + lane * 4 + 256 * j);
            if (part && !lat) {
                const size_t po = (size_t)(row - ML) * D + lane * 4 + 256 * j;
                const f32x4 p0 = *(const f32x4*)(part + po), p1 = *(const f32x4*)(part + (size_t)MC * D + po), p2 = *(const f32x4*)(part + (size_t)2 * MC * D + po), p3 = *(const f32x4*)(part + (size_t)3 * MC * D + po);
                v[j] = v[j] + *(const f32x4*)(pgate + lane * 4 + 256 * j) * ((p0 + p1) + (p2 + p3));
                *(f32x4*)(xc_out + po) = v[j]; }
            ss += (v[j][0] * v[j][0] + v[j][1] * v[j][1]) + (v[j][2] * v[j][2] + v[j][3] * v[j][3]); }
        return ss; };
    auto st = [&](const int row, const f32x4 (&v)[4], const float rs) __attribute__((always_inline)) {
        const float* mp = modl + (size_t)((row < ML) ? (row >> 12) : 16) * 6144;
#pragma unroll
        for (int j = 0; j < 4; ++j) { const int c = lane * 4 + 256 * j;
            const f32x4 gg = *(const f32x4*)(g + c), sh = *(const f32x4*)(mp + cshift * 1024 + c), scl = *(const f32x4*)(mp + cscale * 1024 + c);
            const f32x4 y = (v[j] * rs) * gg * (scl + 1.f) + sh;
            u32x2 o; o.x = pk2(y[0], y[1]); o.y = pk2(y[2], y[3]);
            *(u32x2*)(H + (size_t)row * D + c) = o; } };
    for (int row = gw * 4; row < (nrows < ML ? nrows : ML); row += NGW * 4) {
        f32x4 vA[4], vB[4], vC[4], vD[4];
        float sA = ld(row, vA), sB = ld(row + 1, vB), sC = ld(row + 2, vC), sD = ld(row + 3, vD);
#pragma unroll
        for (int o = 1; o < 64; o <<= 1) { sA += __shfl_xor(sA, o); sB += __shfl_xor(sB, o); sC += __shfl_xor(sC, o); sD += __shfl_xor(sD, o); }
        st(row, vA, rsqrtf(sA * (1.f / D) + EPS)); st(row + 1, vB, rsqrtf(sB * (1.f / D) + EPS));
        st(row + 2, vC, rsqrtf(sC * (1.f / D) + EPS)); st(row + 3, vD, rsqrtf(sD * (1.f / D) + EPS));
    }
    for (int row = ML + gw * 2; row < nrows; row += NGW * 2) {
        f32x4 vA[4], vB[4];
        float sA = ld(row, vA), sB = ld(row + 1, vB);
#pragma unroll
        for (int o = 1; o < 64; o <<= 1) { sA += __shfl_xor(sA, o); sB += __shfl_xor(sB, o); }
        st(row, vA, rsqrtf(sA * (1.f / D) + EPS)); st(row + 1, vB, rsqrtf(sB * (1.f / D) + EPS));
    }
}

DI void prep_phase(const KArgs& a, int zz, int e, const bf16_t* Z, const bf16_t* QP, const bf16_t* KVP, bf16_t* Qb, bf16_t* Kb, bf16_t* VT, LAS unsigned char* lds, int G, int bid, int tid, int wave, int lane) {
    const f32x2* taba = (const f32x2*)(a.ws + zz + OFF_TABA);
    const float* qn_g = a.in[zz + 15] + e * 96; const float* kn_g = a.in[zz + 16] + e * 96;
    const int gt = bid * NTHREADS + tid, GT = G * NTHREADS;
    for (int gidx = gt; gidx < M * 8; gidx += GT) {
        const int row = gidx >> 3, h = gidx & 7;
        const bool lat = row < ML; int b, pos, t = 0;
        if (lat) { b = row >> 12; t = row & 4095; pos = TC + t; } else { const int rc = row - ML; b = rc >> 8; pos = rc & 255; }
        const bf16_t* zr = Z + (size_t)row * ZW;
        float f[8];
        float ss = 0.f;
#pragma unroll
        for (int i = 0; i < 4; ++i) { unpack8(*(const u32x4*)(zr + h * 32 + i * 8), f);
#pragma unroll
            for (int q = 0; q < 8; ++q) ss += f[q] * f[q]; }
        ss += __shfl_xor(ss, 1); ss += __shfl_xor(ss, 2); ss += __shfl_xor(ss, 4);
        const float rs_q = rsqrtf(ss * (1.f / 256.f) + EPS);
        ss = 0.f;
#pragma unroll
        for (int i = 0; i < 2; ++i) { unpack8(*(const u32x4*)(zr + 256 + h * 16 + i * 8), f);
#pragma unroll
            for (int q = 0; q < 8; ++q) ss += f[q] * f[q]; }
        ss += __shfl_xor(ss, 1); ss += __shfl_xor(ss, 2); ss += __shfl_xor(ss, 4);
        const float rs_kv = rsqrtf(ss * (1.f / 128.f) + EPS);
        {
            const bf16_t* src = QP + (size_t)row * 768 + h * 96;
            bf16_t* dst = Qb + ((size_t)(b * 8 + h) * TK + pos) * 96;
            u32x4 qr[12];
#pragma unroll
            for (int i = 0; i < 12; ++i) qr[i] = *(const u32x4*)(src + i * 8);
            float s2 = 0.f;
#pragma unroll
            for (int i = 0; i < 12; ++i) { unpack8(qr[i], f);
#pragma unroll
                for (int q = 0; q < 8; ++q) { const float v = f[q] * rs_q; s2 += v * v; } }
            const float fs = rs_q * rsqrtf(s2 * (1.f / 96.f) + EPS);
#pragma unroll
            for (int i = 0; i < 8; ++i) { unpack8(qr[i], f); float o[8];
#pragma unroll
                for (int q = 0; q < 8; ++q) o[q] = f[q] * fs * qn_g[i * 8 + q] * QSCALE;
                *(u32x4*)(dst + i * 8) = pack8(o); }
#pragma unroll
            for (int i = 0; i < 2; ++i) { float f2[8], o1[8], o2[8]; unpack8(qr[8 + i], f); unpack8(qr[10 + i], f2);
#pragma unroll
                for (int q = 0; q < 8; ++q) { const float x1 = f[q] * fs * qn_g[64 + i * 8 + q], x2 = f2[q] * fs * qn_g[80 + i * 8 + q];
                    float c = 1.f, s = 0.f; if (lat) { const f32x2 cs = taba[t * 16 + i * 8 + q]; c = cs[0]; s = cs[1]; }
                    o1[q] = (x1 * c - x2 * s) * QSCALE; o2[q] = (x1 * s + x2 * c) * QSCALE; }
                *(u32x4*)(dst + 64 + i * 8) = pack8(o1); *(u32x4*)(dst + 80 + i * 8) = pack8(o2); }
        }
        {
            const bf16_t* src = KVP + (size_t)row * 1024 + h * 128;
            const bf16_t* kr = zr + 384;
            bf16_t* dst = Kb + ((size_t)(b * 8 + h) * TK + pos) * 96;
            u32x4 kn[8], kq[4];
#pragma unroll
            for (int i = 0; i < 8; ++i) kn[i] = *(const u32x4*)(src + i * 8);
#pragma unroll
            for (int i = 0; i < 4; ++i) kq[i] = *(const u32x4*)(kr + i * 8);
            float s2 = 0.f;
#pragma unroll
            for (int i = 0; i < 8; ++i) { unpack8(kn[i], f);
#pragma unroll
                for (int q = 0; q < 8; ++q) { const float v = f[q] * rs_kv; s2 += v * v; } }
#pragma unroll
            for (int i = 0; i < 4; ++i) { unpack8(kq[i], f);
#pragma unroll
                for (int q = 0; q < 8; ++q) s2 += f[q] * f[q]; }
            const float ks = rsqrtf(s2 * (1.f / 96.f) + EPS);
            const float fs = rs_kv * ks;
#pragma unroll
            for (int i = 0; i < 8; ++i) { unpack8(kn[i], f); float o[8];
#pragma unroll
                for (int q = 0; q < 8; ++q) o[q] = f[q] * fs * kn_g[i * 8 + q];
                *(u32x4*)(dst + i * 8) = pack8(o); }
#pragma unroll
            for (int i = 0; i < 2; ++i) { float f2[8], o1[8], o2[8]; unpack8(kq[i], f); unpack8(kq[2 + i], f2);
#pragma unroll
                for (int q = 0; q < 8; ++q) { const float x1 = f[q] * ks * kn_g[64 + i * 8 + q], x2 = f2[q] * ks * kn_g[80 + i * 8 + q];
                    float c = 1.f, s = 0.f; if (lat) { const f32x2 cs = taba[t * 16 + i * 8 + q]; c = cs[0]; s = cs[1]; }
                    o1[q] = x1 * c - x2 * s; o2[q] = x1 * s + x2 * c; }
                *(u32x4*)(dst + 64 + i * 8) = pack8(o1); *(u32x4*)(dst + 80 + i * 8) = pack8(o2); }
        }
    }
    {
        const int gw = bid * 8 + wave, NGW = G * 8;
        LAS bf16_t* tl = (LAS bf16_t*)(lds + wave * 8704);
        for (int u = (gw + NGW / 2) % NGW; u < (M / 64) * 2; u += NGW) {
            const int rb = u >> 1, hh = (u & 1) * 4; const int row = rb * 64 + lane, rowb = rb * 64;
            int b, posb;
            if (rowb < ML) { b = rowb >> 12; posb = TC + (rowb & 4095); } else { const int rc = rowb - ML; b = rc >> 8; posb = rc & 255; }
            const bf16_t* zr = Z + (size_t)row * ZW + 256;
            float f[8]; float ss = 0.f;
#pragma unroll
            for (int i = 0; i < 16; ++i) { unpack8(*(const u32x4*)(zr + i * 8), f);
#pragma unroll
                for (int q = 0; q < 8; ++q) ss += f[q] * f[q]; }
            const float rs_kv = rsqrtf(ss * (1.f / 128.f) + EPS);
            for (int h = hh; h < hh + 4; ++h) {
                const bf16_t* src = KVP + (size_t)row * 1024 + h * 128 + 64;
#pragma unroll
                for (int ch = 0; ch < 8; ++ch) { unpack8(*(const u32x4*)(src + ch * 8), f);
#pragma unroll
                    for (int q = 0; q < 8; ++q) f[q] *= rs_kv;
                    const u32x4 w = pack8(f);
                    *(LAS u32x2*)(tl + lane * 68 + ch * 8) = (u32x2){w.x, w.y}; *(LAS u32x2*)(tl + lane * 68 + ch * 8 + 4) = (u32x2){w.z, w.w}; }
                LDS_WAIT();
                bf16_t* dst = VT + ((size_t)(b * 8 + h) * 64 + lane) * TK + posb;
#pragma unroll
                for (int c = 0; c < 8; ++c) { const int base = (c >> 1) * 16 + (c & 1) * 4; unsigned v[8];
#pragma unroll
                    for (int k = 0; k < 8; ++k) v[k] = tl[(base + (k & 3) + (k >> 2) * 8) * 68 + lane];
                    u32x4 o; o.x = v[0] | (v[1] << 16); o.y = v[2] | (v[3] << 16); o.z = v[4] | (v[5] << 16); o.w = v[6] | (v[7] << 16);
                    *(u32x4*)(dst + c * 8) = o; }
                LDS_WAIT();
            }
        }
    }
}

constexpr int AT_KB = 64 * 104 * 2, AT_VB = 64 * 72 * 2;
DI int crow(int r, int hi) { return (r & 3) + 8 * (r >> 2) + 4 * hi; }
DI void attn_phase(const bf16_t* Qb, const bf16_t* Kb, const bf16_t* VT, bf16_t* MIX, LAS unsigned char* lds, int G, int bid, int tid, int wave, int lane) {
    const int r32 = lane & 31, hi = lane >> 5;
    LAS float* scrw = (LAS float*)(lds + 2 * AT_KB + 2 * AT_VB) + wave * 64;
    constexpr int NU_LAT = NB * 8 * 16, NU = NU_LAT + NB * 8;
    const int vcu = ((G & 7) == 0) ? (bid & 7) * (G >> 3) + (bid >> 3) : bid;
    const int kc0 = tid, kc1 = 512 + tid, kc1c = 512 + (tid & 255);
    const int kl0 = (kc0 / 12) * 208 + (kc0 % 12) * 16, kl1 = (kc1 / 12) * 208 + (kc1 % 12) * 16;
    const int vd = tid >> 3, vch = tid & 7; const int vl = vd * 144 + vch * 16;
    for (int u = vcu; u < NU; u += G) {
        int bh, qpos0, nt; size_t orow0;
        if (u < NU_LAT) { bh = u >> 4; const int qb = u & 15; qpos0 = TC + qb * 256; nt = TK / 64; orow0 = (size_t)(bh >> 3) * T + qb * 256; }
        else { bh = u - NU_LAT; qpos0 = 0; nt = TC / 64; orow0 = (size_t)ML + (size_t)(bh >> 3) * TC; }
        const int h = bh & 7;
        const bf16_t* Kh = Kb + (size_t)bh * TK * 96; const bf16_t* Vh = VT + (size_t)bh * 64 * TK;
        bf16x8 qf[6];
        { const bf16_t* qp = Qb + ((size_t)bh * TK + qpos0 + wave * 32 + r32) * 96 + hi * 8;
#pragma unroll
          for (int d0 = 0; d0 < 6; ++d0) qf[d0] = *(const bf16x8*)(qp + d0 * 16); }
        u32x4 rkA0, rkA1, rvA, rkB0, rkB1, rvB;
#define AT_LOAD(S, kt, vt) do { const int kt_ = (kt) < nt ? (kt) : nt - 1, vt_ = (vt) < nt ? (vt) : nt - 1; const bf16_t* Kt_ = Kh + (size_t)kt_ * 64 * 96; \
        rk##S##0 = *(const u32x4*)(Kt_ + kc0 * 8); rk##S##1 = *(const u32x4*)(Kt_ + kc1c * 8); rv##S = *(const u32x4*)(Vh + (size_t)vd * TK + vt_ * 64 + vch * 8); } while (0)
#define AT_STOREK(S, bb) do { LAS unsigned char* Kn_ = lds + (bb) * AT_KB; *(LAS u32x4*)(Kn_ + kl0) = rk##S##0; if (tid < 256) *(LAS u32x4*)(Kn_ + kl1) = rk##S##1; } while (0)
#define AT_STOREV(S, bb) do { *(LAS u32x4*)(lds + 2 * AT_KB + (bb) * AT_VB + vl) = rv##S; } while (0)
        float lsum = 0.f;
        f32x16 o0, o1, sA0, sA1, sB0, sB1;
#pragma unroll
        for (int r = 0; r < 16; ++r) { o0[r] = 0.f; o1[r] = 0.f; }
        auto qk = [&](f32x16& s0, f32x16& s1, const int kbuf) __attribute__((always_inline)) {
            const LAS unsigned char* Kl = lds + kbuf * AT_KB;
            f32x16 z;
#pragma unroll
            for (int r = 0; r < 16; ++r) z[r] = 0.f;
#pragma unroll
            for (int d0 = 0; d0 < 6; ++d0) {
                const bf16x8 a0 = *(const LAS bf16x8*)(Kl + r32 * 208 + d0 * 32 + hi * 16);
                const bf16x8 a1 = *(const LAS bf16x8*)(Kl + (32 + r32) * 208 + d0 * 32 + hi * 16);
                if (d0 == 0) { s0 = MFMA32(a0, qf[0], z); s1 = MFMA32(a1, qf[0], z); }
                else { s0 = MFMA32(a0, qf[d0], s0); s1 = MFMA32(a1, qf[d0], s1); }
            }
        };
        auto softmax_pack = [&](f32x16& s0, f32x16& s1, bf16x8 (&pa)[4]) __attribute__((always_inline)) {
            float ps0 = 0.f, ps1 = 0.f;
#pragma unroll
            for (int r = 0; r < 16; ++r) { s0[r] = __builtin_amdgcn_exp2f(s0[r]); s1[r] = __builtin_amdgcn_exp2f(s1[r]); ps0 += s0[r]; ps1 += s1[r]; }
            lsum += ps0 + ps1;
            u32x4 w;
            w.x = pk2(s0[0], s0[1]); w.y = pk2(s0[2], s0[3]); w.z = pk2(s0[4], s0[5]); w.w = pk2(s0[6], s0[7]); pa[0] = __builtin_bit_cast(bf16x8, w);
            w.x = pk2(s0[8], s0[9]); w.y = pk2(s0[10], s0[11]); w.z = pk2(s0[12], s0[13]); w.w = pk2(s0[14], s0[15]); pa[1] = __builtin_bit_cast(bf16x8, w);
            w.x = pk2(s1[0], s1[1]); w.y = pk2(s1[2], s1[3]); w.z = pk2(s1[4], s1[5]); w.w = pk2(s1[6], s1[7]); pa[2] = __builtin_bit_cast(bf16x8, w);
            w.x = pk2(s1[8], s1[9]); w.y = pk2(s1[10], s1[11]); w.z = pk2(s1[12], s1[13]); w.w = pk2(s1[14], s1[15]); pa[3] = __builtin_bit_cast(bf16x8, w);
        };
        auto pv = [&](const bf16x8 (&pa)[4], const int vbuf) __attribute__((always_inline)) {
            const LAS unsigned char* Vl = lds + 2 * AT_KB + vbuf * AT_VB;
#pragma unroll
            for (int kk = 0; kk < 4; ++kk) {
                const LAS unsigned char* vp = Vl + r32 * 144 + kk * 32 + hi * 16;
                const bf16x8 b0 = *(const LAS bf16x8*)(vp);
                const bf16x8 b1 = *(const LAS bf16x8*)(vp + 32 * 144);
                o0 = MFMA32(pa[kk], b0, o0); o1 = MFMA32(pa[kk], b1, o1);
            }
        };
        AT_LOAD(A, 0, 0); AT_LOAD(B, 1, 1);
        AT_STOREK(A, 0); AT_STOREV(A, 0); AT_STOREK(B, 1);
        AT_LOAD(B, 2, 1);
        __syncthreads();
        qk(sA0, sA1, 0);
        __syncthreads();
#define AT_STEP(sc0, sc1, sn0, sn1, tt, par, LS, SS) do { \
            AT_LOAD(LS, (tt) + 3, (tt) + 2); \
            bf16x8 pa_[4]; \
            qk(sn0, sn1, (par) ^ 1); \
            softmax_pack(sc0, sc1, pa_); \
            pv(pa_, (par)); \
            AT_STOREK(SS, (par)); AT_STOREV(SS, (par) ^ 1); \
            __syncthreads(); } while (0)
        int t = 0;
        for (; t + 2 < nt; t += 2) { AT_STEP(sA0, sA1, sB0, sB1, t, 0, A, B); AT_STEP(sB0, sB1, sA0, sA1, t + 1, 1, B, A); }
        AT_STEP(sA0, sA1, sB0, sB1, t, 0, A, B);
        { bf16x8 pa_[4]; softmax_pack(sB0, sB1, pa_); pv(pa_, 1); }
#undef AT_STEP
#undef AT_LOAD
#undef AT_STOREK
#undef AT_STOREV
        lsum += __shfl_xor(lsum, 32);
        scrw[r32] = __builtin_amdgcn_rcpf(lsum);
        LDS_WAIT();
        bf16_t* op = MIX + (orow0 + wave * 32) * D + h * 64 + r32;
#pragma unroll
        for (int r = 0; r < 16; ++r) { const int q = crow(r, hi); const float il = scrw[q];
            op[(size_t)q * D] = f2bf(o0[r] * il); op[(size_t)q * D + 32] = f2bf(o1[r] * il); }
        LDS_WAIT();
        __syncthreads();
    }
}

constexpr int RT_Q = 0, RT_K = 18432, RT_KT = 36864, RT_VT = 54272, RT_ST = 71680;
DI void ret_phase(const KArgs& a, int zz, int e, const bf16_t* Z, bf16_t* OF, bf16_t* OB, LAS unsigned char* lds, int G, int bid, int tid, int wave, int lane) {
    const f32x2* tabr = (const f32x2*)(a.ws + zz + OFF_TABR);
    const int fr = lane & 15, fq = lane >> 4;
    LAS bf16_t* Qs = (LAS bf16_t*)(lds + RT_Q); LAS bf16_t* Ks = (LAS bf16_t*)(lds + RT_K); LAS bf16_t* KTs = (LAS bf16_t*)(lds + RT_KT);
    LAS bf16_t* VTs = (LAS bf16_t*)(lds + RT_VT); LAS bf16_t* STs = (LAS bf16_t*)(lds + RT_ST);
    for (int u = bid; u < NB * 8 * 2; u += G) {
        const int dir = u & 1, h = (u >> 1) & 7, b = u >> 4;
        bf16_t* O = dir ? OB : OF;
        const float raw = a.in[zz + (dir ? 18 : 17)][e * 8 + h];
        const float lg2 = log1pf(-exp2f(raw)) * LOG2E;
        const float cd = exp2f(128.f * lg2);
        for (int i = tid; i < 64 * 72 / 2; i += NTHREADS) ((LAS unsigned*)STs)[i] = 0u;
        f32x4 sacc[2]; sacc[0] = (f32x4){0.f, 0.f, 0.f, 0.f}; sacc[1] = (f32x4){0.f, 0.f, 0.f, 0.f};
        const int et_s = wave >> 1, dt0 = (wave & 1) * 2;
        __syncthreads();
        u32x4 fq1_, fq2_, fk1_, fk2_, fv1_, fv2_;
        auto chunk_row0 = [&](const int ci, int& t0o, bool& sego) __attribute__((always_inline)) -> size_t {
            const int cc = ci < 34 ? ci : 33; const bool seg = cc < 2; const int k = seg ? cc : cc - 2, nch = seg ? 2 : 32, cidx = dir ? nch - 1 - k : k;
            t0o = cidx * 128; sego = seg;
            return seg ? (size_t)ML + b * TC + cidx * 128 : (size_t)b * T + cidx * 128; };
        auto issue = [&](const int ci) __attribute__((always_inline)) {
            int t0d; bool sd; const size_t r0 = chunk_row0(ci, t0d, sd);
            const bf16_t* zr = Z + (r0 + (tid >> 2)) * ZW + h * 64; const int c = tid & 3;
            fq1_ = *(const u32x4*)(zr + 512 + c * 8); fq2_ = *(const u32x4*)(zr + 512 + 32 + c * 8);
            fk1_ = *(const u32x4*)(zr + 1024 + c * 8); fk2_ = *(const u32x4*)(zr + 1024 + 32 + c * 8);
            fv1_ = *(const u32x4*)(zr + 1536 + c * 16); fv2_ = *(const u32x4*)(zr + 1536 + c * 16 + 8); };
        issue(0);
        for (int ci = 0; ci < 34; ++ci) {
            int t0; bool seg; const size_t row0 = chunk_row0(ci, t0, seg);
            {
                const int r = tid >> 2, c = tid & 3;
                float x1[8], x2[8], o1[8], o2[8];
                unpack8(fq1_, x1); unpack8(fq2_, x2);
                f32x2 cs[8];
#pragma unroll
                for (int i = 0; i < 8; ++i) cs[i] = seg ? (f32x2){1.f, 0.f} : tabr[(size_t)(t0 + r) * 32 + c * 8 + i];
#pragma unroll
                for (int i = 0; i < 8; ++i) { o1[i] = x1[i] * cs[i][0] - x2[i] * cs[i][1]; o2[i] = x1[i] * cs[i][1] + x2[i] * cs[i][0]; }
                *(LAS u32x4*)(Qs + r * 72 + c * 8) = pack8(o1); *(LAS u32x4*)(Qs + r * 72 + 32 + c * 8) = pack8(o2);
                unpack8(fk1_, x1); unpack8(fk2_, x2);
#pragma unroll
                for (int i = 0; i < 8; ++i) { o1[i] = (x1[i] * cs[i][0] - x2[i] * cs[i][1]) * 0.125f; o2[i] = (x1[i] * cs[i][1] + x2[i] * cs[i][0]) * 0.125f; }
                *(LAS u32x4*)(Ks + r * 72 + c * 8) = pack8(o1); *(LAS u32x4*)(Ks + r * 72 + 32 + c * 8) = pack8(o2);
                const float kd = __builtin_amdgcn_exp2f((float)(dir ? r : 127 - r) * lg2);
#pragma unroll
                for (int i = 0; i < 8; ++i) { KTs[(c * 8 + i) * 136 + r] = f2bf(o1[i] * kd); KTs[(32 + c * 8 + i) * 136 + r] = f2bf(o2[i] * kd); }
                unpack8(fv1_, x1); unpack8(fv2_, x2);
#pragma unroll
                for (int i = 0; i < 8; ++i) { VTs[(c * 16 + i) * 136 + r] = f2bf(x1[i]); VTs[(c * 16 + 8 + i) * 136 + r] = f2bf(x2[i]); }
            }
            __syncthreads();
            issue(ci + 1);
            {
                const int il = 16 * wave + fr;
                bf16x8 Qf[2];
#pragma unroll
                for (int ks = 0; ks < 2; ++ks) Qf[ks] = *(const LAS bf16x8*)(Qs + il * 72 + ks * 32 + fq * 8);
                f32x4 st[8];
#pragma unroll
                for (int jt = 0; jt < 8; ++jt) { st[jt] = (f32x4){0.f, 0.f, 0.f, 0.f};
#pragma unroll
                    for (int ks = 0; ks < 2; ++ks) { const bf16x8 A = *(const LAS bf16x8*)(Ks + (16 * jt + fr) * 72 + ks * 32 + fq * 8); st[jt] = MFMA16(A, Qf[ks], st[jt]); } }
                bf16x8 Pf[4];
#pragma unroll
                for (int kk = 0; kk < 4; ++kk) { float p[8];
#pragma unroll
                    for (int q = 0; q < 8; ++q) { const int jt = 2 * kk + (q >> 2), jj = q & 3; const int j = 16 * jt + fq * 4 + jj;
                        const int diff = dir ? j - il : il - j; const bool valid = dir ? diff > 0 : diff >= 0;
                        p[q] = valid ? st[jt][jj] * __builtin_amdgcn_exp2f((float)diff * lg2) : 0.f; }
                    Pf[kk] = __builtin_bit_cast(bf16x8, pack8(p)); }
                const float qd = __builtin_amdgcn_exp2f((float)(dir ? 128 - il : il + 1) * lg2);
#pragma unroll
                for (int et = 0; et < 4; ++et) {
                    f32x4 oa = (f32x4){0.f, 0.f, 0.f, 0.f}, o2 = (f32x4){0.f, 0.f, 0.f, 0.f};
#pragma unroll
                    for (int kk = 0; kk < 4; ++kk) { const LAS bf16_t* vp = VTs + (16 * et + fr) * 136 + 32 * kk + fq * 4;
                        const s16x4 lo = *(const LAS s16x4*)(vp), hi4 = *(const LAS s16x4*)(vp + 16);
                        const bf16x8 A = __builtin_shufflevector(lo, hi4, 0, 1, 2, 3, 4, 5, 6, 7);
                        oa = MFMA16(A, Pf[kk], oa); }
#pragma unroll
                    for (int ks = 0; ks < 2; ++ks) { const bf16x8 A = *(const LAS bf16x8*)(STs + (16 * et + fr) * 72 + ks * 32 + fq * 8); o2 = MFMA16(A, Qf[ks], o2); }
                    const f32x4 ov = oa + o2 * qd;
                    u32x2 w; w.x = pk2(ov[0], ov[1]); w.y = pk2(ov[2], ov[3]);
                    *(u32x2*)(O + (row0 + il) * 512 + h * 64 + 16 * et + fq * 4) = w;
                }
#pragma unroll
                for (int q = 0; q < 2; ++q) { const int dt = dt0 + q; sacc[q] = sacc[q] * cd;
#pragma unroll
                    for (int kk = 0; kk < 4; ++kk) { const bf16x8 A = *(const LAS bf16x8*)(VTs + (16 * et_s + fr) * 136 + 32 * kk + fq * 8);
                        const bf16x8 B = *(const LAS bf16x8*)(KTs + (16 * dt + fr) * 136 + 32 * kk + fq * 8); sacc[q] = MFMA16(A, B, sacc[q]); } }
            }
            __syncthreads();
#pragma unroll
            for (int q = 0; q < 2; ++q)
#pragma unroll
                for (int jj = 0; jj < 4; ++jj) STs[(16 * et_s + fq * 4 + jj) * 72 + 16 * (dt0 + q) + fr] = f2bf(sacc[q][jj]);
        }
        __syncthreads();
    }
}

DI void retcomb_phase(const bf16_t* Z, const bf16_t* OF, const bf16_t* OB, bf16_t* MIX, int gw, int NGW, int lane) {
    for (int row = gw; row < M; row += NGW) {
        float f1[8], f2[8], g[8], o[8];
        unpack8(*(const u32x4*)(OF + (size_t)row * 512 + lane * 8), f1); unpack8(*(const u32x4*)(OB + (size_t)row * 512 + lane * 8), f2);
        unpack8(*(const u32x4*)(Z + (size_t)row * ZW + 2048 + lane * 8), g);
        float s = 0.f;
#pragma unroll
        for (int q = 0; q < 8; ++q) { o[q] = f1[q] + f2[q]; s += o[q]; }
        s += __shfl_xor(s, 1); s += __shfl_xor(s, 2); s += __shfl_xor(s, 4);
        const float mu = s * (1.f / 64.f); float v = 0.f;
#pragma unroll
        for (int q = 0; q < 8; ++q) { o[q] -= mu; v += o[q] * o[q]; }
        v += __shfl_xor(v, 1); v += __shfl_xor(v, 2); v += __shfl_xor(v, 4);
        const float rs = rsqrtf(v * (1.f / 64.f) + EPS);
#pragma unroll
        for (int q = 0; q < 8; ++q) o[q] = o[q] * rs * (g[q] / (1.f + __expf(-g[q])));
        *(u32x4*)(MIX + (size_t)row * D + 512 + lane * 8) = pack8(o);
    }
}

DI void s5_phase(const KArgs& a, int zz, int o, const bf16_t* H, bf16_t* YF, bf16_t* YB, LAS unsigned char* lds, int G, int bid, int wave, int lane) {
    const int fr = lane & 15, fq = lane >> 4;
    LAS float* BU = (LAS float*)(lds + wave * 12800);
    LAS unsigned* XS = (LAS unsigned*)(lds + wave * 12800 + 8448);
    for (int u = bid; u < NB * 16; u += G) {
        const int b = u >> 4, g = (u & 15) * 4 + (wave >> 1), dir = wave & 1;
        const int pb = zz + (dir ? 27 : 20);
        const float* are = a.in[pb + 0] + (size_t)(o * 64 + g) * 64; const float* aim = a.in[pb + 1] + (size_t)(o * 64 + g) * 64;
        const float* bre = a.in[pb + 2] + (size_t)(o * 64 + g) * 64 * 16; const float* bim = a.in[pb + 3] + (size_t)(o * 64 + g) * 64 * 16;
        const float* cre = a.in[pb + 4] + (size_t)(o * 64 + g) * 16 * 64; const float* cim = a.in[pb + 5] + (size_t)(o * 64 + g) * 16 * 64;
        const float dt = __expf(a.in[pb + 6][o * 64 + g]);
        bf16_t* Y = dir ? YB : YF;
        float abr, abi;
        { const float ar = are[lane], ai = aim[lane]; const float mag = __expf(dt * ar); float rev = dt * ai * 0.15915494309189535f; rev -= floorf(rev);
          abr = mag * cos_rev(rev); abi = mag * sin_rev(rev); }
        bf16x8 Bb[8];
#pragma unroll
        for (int nt = 0; nt < 8; ++nt) {
            const int c = 16 * nt + fr, p2 = c >> 1, part = c & 1;
            const float ar = are[p2], ai = aim[p2]; const float mag = __expf(dt * ar); float rev = dt * ai * 0.15915494309189535f; rev -= floorf(rev);
            const float er = mag * cos_rev(rev) - 1.f, ei = mag * sin_rev(rev); const float den = 1.f / (ar * ar + ai * ai);
            const float cr = (er * ar + ei * ai) * den, ci = (ei * ar - er * ai) * den;
            float v[8];
#pragma unroll
            for (int j = 0; j < 8; ++j) v[j] = 0.f;
            if (fq < 2) {
#pragma unroll
                for (int j = 0; j < 8; ++j) { const float br = bre[p2 * 16 + fq * 8 + j], bi = bim[p2 * 16 + fq * 8 + j]; v[j] = part ? (cr * bi + ci * br) : (cr * br - ci * bi); } }
            Bb[nt] = __builtin_bit_cast(bf16x8, pack8(v));
        }
        bf16x8 Cb[4];
#pragma unroll
        for (int kb = 0; kb < 4; ++kb) { float v[8];
#pragma unroll
            for (int j = 0; j < 8; ++j) { const int p3 = kb * 16 + fq * 4 + (j >> 1); v[j] = (j & 1) ? -cim[fr * 64 + p3] : cre[fr * 64 + p3]; }
            Cb[kb] = __builtin_bit_cast(bf16x8, pack8(v)); }
        auto run_dir = [&](auto dirc) __attribute__((always_inline)) {
        constexpr bool DIRC = decltype(dirc)::value;
        float xr = 0.f, xi = 0.f; const float nabi = -abi;
        const bf16_t* Hg = H + g * 16 + (fq & 1) * 8;
        auto chunk_row = [&](int ci) -> size_t { const bool seg = ci < 16; const int k = seg ? ci : ci - 16, nch = seg ? 16 : 256, cidx = DIRC ? nch - 1 - k : k;
            return seg ? (size_t)ML + b * TC + cidx * 16 : (size_t)b * T + cidx * 16; };
#define S5_CB() asm volatile("" ::: "memory")
        auto loadu = [&](const int ci) __attribute__((always_inline)) -> u32x4 {
            const int cc = ci < 272 ? ci : 271;
            u32x4 r = *(const u32x4*)(Hg + (chunk_row(cc) + fr) * D);
            const bool keep = fq < 2;
            r.x = keep ? r.x : 0u; r.y = keep ? r.y : 0u; r.z = keep ? r.z : 0u; r.w = keep ? r.w : 0u;
            return r; };
        auto stageA = [&](const u32x4 uu) __attribute__((always_inline)) {
            const bf16x8 Au = __builtin_bit_cast(bf16x8, uu);
#pragma unroll
            for (int nt = 0; nt < 8; ++nt) { const f32x4 acc = MFMA16(Bb[nt], Au, ((f32x4){0.f, 0.f, 0.f, 0.f}));
                *(LAS f32x4*)(BU + fr * 132 + 16 * nt + fq * 4) = acc; } };
        u32x4 u1 = loadu(1), u2 = loadu(2);
        stageA(loadu(0));
        S5_CB();
        size_t rowprev = 0;
        auto iter = [&](const int ci, const bool do_c) __attribute__((always_inline)) {
            const size_t row0 = chunk_row(ci);
            const u32x4 u3 = loadu(ci + 3);
            f32x2 bu[16];
#pragma unroll
            for (int s = 0; s < 16; ++s) { const int tt = DIRC ? 15 - s : s; bu[s] = *(const LAS f32x2*)(BU + tt * 132 + 2 * lane); }
            bf16x8 Ax[4];
            if (do_c) {
#pragma unroll
                for (int kb = 0; kb < 4; ++kb) Ax[kb] = *(const LAS bf16x8*)(XS + fr * 68 + kb * 16 + fq * 4); }
            S5_CB();
            stageA(u1);
            S5_CB();
#pragma unroll
            for (int s = 0; s < 16; ++s) { const int tt = DIRC ? 15 - s : s;
                const float nr = __builtin_fmaf(abr, xr, __builtin_fmaf(nabi, xi, bu[s][0])); const float ni = __builtin_fmaf(abr, xi, __builtin_fmaf(abi, xr, bu[s][1])); xr = nr; xi = ni;
                XS[tt * 68 + lane] = pk2(xr, xi); }
            if (do_c) {
                f32x4 ya = (f32x4){0.f, 0.f, 0.f, 0.f};
#pragma unroll
                for (int kb = 0; kb < 4; ++kb) ya = MFMA16(Cb[kb], Ax[kb], ya);
                u32x2 w; w.x = pk2(ya[0], ya[1]); w.y = pk2(ya[2], ya[3]); *(u32x2*)(Y + (rowprev + fr) * D + g * 16 + fq * 4) = w; }
            S5_CB();
            rowprev = row0; u1 = u2; u2 = u3;
        };
        iter(0, false);
        for (int ci = 1; ci < 272; ++ci) iter(ci, true);
        {
            f32x4 ya = (f32x4){0.f, 0.f, 0.f, 0.f};
#pragma unroll
            for (int kb = 0; kb < 4; ++kb) { const bf16x8 Ax = *(const LAS bf16x8*)(XS + fr * 68 + kb * 16 + fq * 4); ya = MFMA16(Cb[kb], Ax, ya); }
            u32x2 w; w.x = pk2(ya[0], ya[1]); w.y = pk2(ya[2], ya[3]); *(u32x2*)(Y + (rowprev + fr) * D + g * 16 + fq * 4) = w;
        }
        LDS_WAIT();
        };
        if (dir) run_dir(std::true_type{}); else run_dir(std::false_type{});
#undef S5_CB
    }
}

DI float gelu_tanh(float x) { const float z = 0.7978845608028654f * (x + 0.044715f * x * x * x); const float e = __expf(2.f * z); const float th = 1.f - 2.f / (e + 1.f); return 0.5f * x * (1.f + th); }
DI void s5comb_phase(const bf16_t* H, const bf16_t* YF, const bf16_t* YB, const float* dsk, bf16_t* Gb, int nrows, int gt, int GT) {
    const size_t n8 = (size_t)nrows * (D / 8);
    for (size_t i = gt; i < n8; i += GT) {
        const int c = (int)(i & 127) * 8;
        float u[8], f1[8], f2[8], o[8];
        unpack8(*(const u32x4*)(H + i * 8), u); unpack8(*(const u32x4*)(YF + i * 8), f1); unpack8(*(const u32x4*)(YB + i * 8), f2);
        const f32x4 d0 = *(const f32x4*)(dsk + c), d1 = *(const f32x4*)(dsk + c + 4);
#pragma unroll
        for (int q = 0; q < 8; ++q) { const float dd = q < 4 ? d0[q] : d1[q - 4]; o[q] = gelu_tanh(f1[q] + f2[q] + dd * u[q]); }
        *(u32x4*)(Gb + i * 8) = pack8(o);
    }
}

#define XB_TMO      128
#define XB_XCNT(j)  (256  + 64 * (j))
#define XB_XSUB(j)  (1280 + 64 * (j))
#define XB_XGEN(j)  (2304 + 64 * (j))
#define XB_TOP      3328
#define XB_TOPGEN   3392
#define XCD_BAR_WORDS 3456
#define XB_SPIN_CAP (1u << 22)
DI unsigned xb_ld(unsigned* p)              { return __hip_atomic_load(p, __ATOMIC_RELAXED, __HIP_MEMORY_SCOPE_AGENT); }
DI unsigned xb_add(unsigned* p, unsigned v) { return __hip_atomic_fetch_add(p, v, __ATOMIC_RELAXED, __HIP_MEMORY_SCOPE_AGENT); }
DI unsigned xb_xcc_id() { return (unsigned)__builtin_amdgcn_s_getreg((3 << 11) | 20) & 0xFu; }
#define XB_SPIN(cond, bar) do { unsigned _sp = 0; while (cond) { __builtin_amdgcn_s_sleep(1); \
    if ((++_sp & 255u) == 0u) { if (xb_ld(&(bar)[XB_TMO])) break; if (_sp > XB_SPIN_CAP) { atomicAdd(&(bar)[XB_TMO], 1u); break; } } } } while (0)
struct XcdBarrier { unsigned* bar; unsigned x; volatile LAS unsigned* st; };
DI XcdBarrier xcd_barrier_post(unsigned* bar, volatile LAS unsigned* st) {
    XcdBarrier b; b.bar = bar; b.x = xb_xcc_id(); b.st = st;
    if (threadIdx.x == 0) (void)xb_add(&bar[XB_XCNT(b.x)], 1u);
    return b;
}
DI void xcd_barrier_complete(unsigned* bar, unsigned x, unsigned& nloc, unsigned& nx) {
    const unsigned G = gridDim.x * gridDim.y * gridDim.z;
    unsigned sum, cnt, mine, sp = 0u;
    for (;;) {
        sum = 0u; cnt = 0u; mine = 0u;
#pragma unroll
        for (unsigned j = 0; j < 16; ++j) { const unsigned c = xb_ld(&bar[XB_XCNT(j)]); sum += c; cnt += (c > 0u) ? 1u : 0u; mine = (j == x) ? c : mine; }
        if (sum == G) break;
        __builtin_amdgcn_s_sleep(1);
        if ((++sp & 255u) == 0u) { if (xb_ld(&bar[XB_TMO])) break; if (sp > XB_SPIN_CAP) { atomicAdd(&bar[XB_TMO], 1u); break; } }
    }
    nloc = mine > 0u ? mine : 1u; nx = cnt > 0u ? cnt : 1u;
}
DI void xcd_barrier(const XcdBarrier& b) {
    asm volatile("s_waitcnt vmcnt(0)" ::: "memory");
    __syncthreads();
    if (threadIdx.x == 0) {
        unsigned* bar = b.bar;
        __builtin_amdgcn_s_waitcnt(0);
        unsigned nloc = b.st[0], nx = b.st[1];
        if (nloc == 0u) { xcd_barrier_complete(bar, b.x, nloc, nx); b.st[0] = nloc; b.st[1] = nx; }
        const unsigned old = xb_add(&bar[XB_XSUB(b.x)], 1u);
        const unsigned gen = old / nloc;
        if (old + 1u == (gen + 1u) * nloc) {
            __builtin_amdgcn_fence(__ATOMIC_RELEASE, "agent");
            asm volatile("s_waitcnt vmcnt(0)" ::: "memory");
            const unsigned og = xb_add(&bar[XB_TOP], 1u);
            const unsigned tg = og / nx;
            if (og + 1u == (tg + 1u) * nx) xb_add(&bar[XB_TOPGEN], 1u);
            else XB_SPIN(xb_ld(&bar[XB_TOPGEN]) == tg, bar);
            __builtin_amdgcn_fence(__ATOMIC_ACQUIRE, "agent");
            xb_add(&bar[XB_XGEN(b.x)], 1u);
            asm volatile("s_waitcnt vmcnt(0)" ::: "memory");
        } else {
            XB_SPIN(xb_ld(&bar[XB_XGEN(b.x)]) == gen, bar);
            __builtin_amdgcn_fence(__ATOMIC_ACQUIRE, "agent");
            asm volatile("s_waitcnt vmcnt(0)" ::: "memory");
        }
    }
    __syncthreads();
}

#ifndef EN_MASK
#define EN_MASK 0xffff
#endif
#define EN(k) ((EN_MASK >> (k)) & 1)
#ifndef REP_MASK
#define REP_MASK 0
#endif
#define REPN(k) (1 + ((REP_MASK >> (k)) & 1))
enum { OP_NM1 = 0, OP_GZ, OP_GQP, OP_GKVP, OP_PREP, OP_RETATT, OP_RCOMB, OP_GOUT, OP_S5, OP_S5COMB, OP_GGLU, OP_NM2, OP_GM1, OP_GM2 };
DI int step_op(int s) {
    switch (s) {
        case 0: return OP_NM1; case 1: return OP_GZ; case 2: return OP_GQP; case 3: return OP_PREP; case 4: return OP_RETATT; case 5: return OP_RCOMB;
        case 6: return OP_GOUT; case 7: return OP_NM2; case 8: return OP_GM1; case 9: return OP_GM2;
        case 10: return OP_NM1; case 11: return OP_S5; case 12: return OP_S5COMB; case 13: return OP_GGLU; case 14: return OP_NM2; case 15: return OP_GM1; default: return OP_GM2;
    }
}

__global__ void __launch_bounds__(NTHREADS) fwd_kernel(KArgs a) {
    extern __shared__ __attribute__((aligned(16))) unsigned char lds_raw[];
    LAS unsigned char* lds = (LAS unsigned char*)lds_raw;
    cg::grid_group grid = cg::this_grid();
    volatile LAS unsigned* bst = (volatile LAS unsigned*)(lds + 133120);
    if (threadIdx.x == 0) { bst[0] = 0u; bst[1] = 0u; }
    __syncthreads();
    XcdBarrier xbar = xcd_barrier_post((unsigned*)(a.ws + OFF_BAR), bst);
    { const int tid = threadIdx.x, lane = tid & 63, wave = __builtin_amdgcn_readfirstlane(tid >> 6);
      if (EN(0)) phase0(a, lds, gridDim.x, blockIdx.x, tid, wave, lane); }

    if (a.ws == nullptr) grid.sync();
    xcd_barrier(xbar);

    for (int step = 0; step < 34; ++step) {
        int zz = 0; asm volatile("" : "+s"(zz));
        int tid = threadIdx.x; asm volatile("" : "+v"(tid));
        int G = gridDim.x, bid = blockIdx.x; asm volatile("" : "+s"(G), "+s"(bid));
        const int lane = tid & 63, wave = __builtin_amdgcn_readfirstlane(tid >> 6);
        const int gw = bid * 8 + wave, NGW = G * 8, gt = bid * NTHREADS + tid, GT = G * NTHREADS;
        unsigned char* ws = a.ws + zz; unsigned char* ar = ws + OFF_ARENA;
        float* XC = (float*)(ws + OFF_XC); float* outp = a.out + zz;
        const float* mod = (const float*)(ws + OFF_MOD);
        const int s18 = step % 17, l = (step / 17) * 2 + (s18 >= 10 ? 1 : 0), op = step_op(s18), e = l >> 1;
        const bool first = (l == 0) && (s18 < 7);
        const float* xl = first ? a.in[zz + 0] : outp; const float* xc = first ? a.in[zz + 2] : XC;
        const float* modl = mod + (size_t)l * 17 * 6144;
        const int Mrows = (l == 3) ? ML : M;
        int gkind = 0; pg8::Gemm gm{nullptr, nullptr, 0, 0, 0, 0}; bf16_t* gout = nullptr; int gldc = 0, gact = 0, gchunk = 0;
        switch (op) {
            case OP_NM1: for (int rep = 0; rep < REPN(1); ++rep) normmod_phase(xl, xc, a.in[zz + 6] + l * D, modl, 0, 1, (bf16_t*)(ar + ((l & 1) ? A_H0 : A_HB)), M, gw, NGW, lane,
                                   l > 0 ? (const float*)(ar + A_PART) : nullptr, modl - (size_t)17 * 6144 + (size_t)16 * 6144 + 5 * 1024, XC); break;
            case OP_NM2: for (int rep = 0; rep < REPN(1); ++rep) normmod_phase(xl, (l == 0) ? a.in[zz + 2] : xc, a.in[zz + 7] + l * D, modl, 3, 4, (bf16_t*)(ar + A_H0), Mrows, gw, NGW, lane,
                                   (l & 1) ? nullptr : (const float*)(ar + A_PART), modl + (size_t)16 * 6144 + 2 * 1024, XC); break;
            case OP_GZ: gkind = 1; gm = pg8::Gemm{(const bf16_t*)(ar + A_HB), (const bf16_t*)(ws + OFF_WINT) + (size_t)e * ZW * D, D, D, M, ZW, D, 1}; gout = (bf16_t*)(ar + A_Z); gldc = ZW; break;
            case OP_GQP: gkind = 1; gm = pg8::Gemm{(const bf16_t*)(ar + A_Z), (const bf16_t*)(ws + OFF_WUQT) + (size_t)e * 768 * 256, ZW, 256, M, 768, 256, 1}; gout = (bf16_t*)(ar + A_MIX); gldc = 768; break;
            case OP_GM1: gkind = 1; gm = pg8::Gemm{(const bf16_t*)(ar + A_H0), (const bf16_t*)(ws + OFF_W1T) + (size_t)l * FF * D, D, D, Mrows, FF, D, 1}; gout = (bf16_t*)(ar + A_HID); gldc = FF; gact = 1; break;
            case OP_GOUT: gkind = 2; gm = pg8::Gemm{(const bf16_t*)(ar + A_MIX), (const bf16_t*)(ws + OFF_WOUTT) + (size_t)e * D * D, D, D, ML, D, D, 1}; gchunk = 2; break;
            case OP_GM2: gkind = 2; gm = pg8::Gemm{(const bf16_t*)(ar + A_HID), (const bf16_t*)(ws + OFF_W2T) + (size_t)l * D * FF, FF, FF, ML, D, FF, 1}; gchunk = 5; break;
            case OP_GGLU: gkind = 3; gm = pg8::Gemm{(const bf16_t*)(ar + A_G), (const bf16_t*)(ws + OFF_WGLUT) + (size_t)(l >> 1) * 2048 * D, D, D, Mrows, 2048, D, 1}; gchunk = 2; break;
            case OP_PREP: for (int rep = 0; rep < REPN(2); ++rep) prep_phase(a, zz, e, (const bf16_t*)(ar + A_Z), (const bf16_t*)(ar + A_MIX), (const bf16_t*)(ar + A_HB), (bf16_t*)(ar + A_Q), (bf16_t*)(ar + A_K), (bf16_t*)(ar + A_VT), lds, G, bid, tid, wave, lane); break;
            case OP_RETATT:
                for (int rep = 0; rep < REPN(3); ++rep) ret_phase(a, zz, e, (const bf16_t*)(ar + A_Z), (bf16_t*)(ar + A_HB), (bf16_t*)(ar + A_HB) + (size_t)M * 512, lds, G, bid, tid, wave, lane);
                for (int rep = 0; rep < REPN(4); ++rep) attn_phase((const bf16_t*)(ar + A_Q), (const bf16_t*)(ar + A_K), (const bf16_t*)(ar + A_VT), (bf16_t*)(ar + A_MIX), lds, G, bid, tid, wave, lane);
                break;
            case OP_RCOMB: for (int rep = 0; rep < REPN(5); ++rep) retcomb_phase((const bf16_t*)(ar + A_Z), (const bf16_t*)(ar + A_HB), (const bf16_t*)(ar + A_HB) + (size_t)M * 512, (bf16_t*)(ar + A_MIX), gw, NGW, lane); break;
            case OP_S5: for (int rep = 0; rep < REPN(6); ++rep) s5_phase(a, zz, l >> 1, (const bf16_t*)(ar + A_H0), (bf16_t*)(ar + A_YF), (bf16_t*)(ar + A_YB), lds, G, bid, wave, lane); break;
            case OP_S5COMB: for (int rep = 0; rep < REPN(7); ++rep) s5comb_phase((const bf16_t*)(ar + A_H0), (const bf16_t*)(ar + A_YF), (const bf16_t*)(ar + A_YB), a.in[zz + 34] + (l >> 1) * D, (bf16_t*)(ar + A_G), Mrows, gt, GT); break;
            default: break;
        }
        const int ngemm = (op == OP_GQP || op == OP_GOUT || (op == OP_GM2 && l < 3)) ? 2 : 1;
        int tidg = threadIdx.x; asm volatile("" : "+v"(tidg));
        if (gkind) for (int gi = 0; gi < ngemm; ++gi) {
            if (gi == 1) {
                if (op == OP_GQP) { gm = pg8::Gemm{(const bf16_t*)(ar + A_Z) + 256, (const bf16_t*)(ws + OFF_WUKVT) + (size_t)e * 1024 * 256, ZW, 256, M, 1024, 256, 1}; gout = (bf16_t*)(ar + A_HB); gldc = 1024; }
                else if (op == OP_GOUT) { gkind = 4; gm = pg8::Gemm{(const bf16_t*)(ar + A_MIX) + (size_t)ML * D, (const bf16_t*)(ws + OFF_WOUTT) + (size_t)e * D * D, D, D, MC, D, D / 4, 4}; }
                else { gkind = 4; gm = pg8::Gemm{(const bf16_t*)(ar + A_HID) + (size_t)ML * FF, (const bf16_t*)(ws + OFF_W2T) + (size_t)l * D * FF, FF, FF, MC, D, FF / 4, 4}; }
            }
            pg8::StaticOrder S; S.init(gm.M, gm.N, G, (gi == 1 && op == OP_GQP) ? (bid + G / 2) % G : bid, gm.ksplit);
            if (gkind == 1) { pg8::EpiStore E{gout, gldc, gact}; pg8::gemm_phase(lds, tidg, gm, S, E); }
            else if (gkind == 2) { pg8::EpiResid E{xl, xc, outp, XC, modl + gchunk * 1024}; pg8::gemm_phase(lds, tidg, gm, S, E); }
            else if (gkind == 3) { pg8::EpiGlu E{xl, xc, outp, XC, modl + gchunk * 1024}; pg8::gemm_phase(lds, tidg, gm, S, E); }
            else { pg8::EpiPart E{(float*)(ar + A_PART), MC}; pg8::gemm_phase(lds, tidg, gm, S, E); }
        }
        xcd_barrier(xbar);
        if (REPN(15) > 1) xcd_barrier(xbar);
    }
}

extern "C" void kernel_launch(void* const* d_in, const int* in_sizes, int n_in, void* d_out, int out_size, void* d_ws, size_t ws_size, hipStream_t stream) {
    static int grid_blocks = 0;
    if (!grid_blocks) {
        if (n_in != 36 || out_size != ML * D || ws_size < WS_NEED) { fprintf(stderr, "kernel_launch: unexpected problem (n_in %d, out %d, ws %zu < %zu)\n", n_in, out_size, ws_size, (size_t)WS_NEED); grid_blocks = -1; return; }
        int dev = 0, cus = 0, per_cu = 0;
        (void)hipGetDevice(&dev);
        (void)hipDeviceGetAttribute(&cus, hipDeviceAttributeMultiprocessorCount, dev);
        (void)hipFuncSetAttribute((const void*)fwd_kernel, hipFuncAttributeMaxDynamicSharedMemorySize, LDS_BYTES);
        (void)hipOccupancyMaxActiveBlocksPerMultiprocessor(&per_cu, (const void*)fwd_kernel, NTHREADS, LDS_BYTES);
        if (per_cu < 1) per_cu = 1;
        grid_blocks = cus * per_cu;
    }
    if (grid_blocks < 0) return;
    if (hipMemsetAsync((unsigned char*)d_ws + OFF_BAR, 0, BAR_BYTES, stream) != hipSuccess) { fprintf(stderr, "kernel_launch: memset of barrier words failed\n"); return; }
    KArgs a{};
    for (int i = 0; i < 36; ++i) a.in[i] = (const float*)d_in[i];
    a.out = (float*)d_out; a.ws = (unsigned char*)d_ws;
    void* args[] = {&a};
    hipError_t err = hipLaunchCooperativeKernel((void*)fwd_kernel, dim3(grid_blocks), dim3(NTHREADS), args, LDS_BYTES, stream);
    if (err != hipSuccess) fprintf(stderr, "cooperative launch failed: %s (grid %d)\n", hipGetErrorString(err), grid_blocks);
}
```
